# Optimizing an MI355X kernel written in HIP

```python
import math
import jax, jax.numpy as jnp
from jax import lax
import numpy as np

D_MODEL = 1024
BATCH = 8
SEQ = 8192
DEPTH = 1

D_MIX = D_MODEL
DIFF_WIDTH = D_MIX // 2
GLA_WIDTH = D_MIX - DIFF_WIDTH
DIFF_HEADS = 4
DIFF_V_DIM = DIFF_WIDTH // DIFF_HEADS
DIFF_QK_DIM = DIFF_V_DIM // 2
GLA_HEADS = 4
GLA_V_DIM = GLA_WIDTH // GLA_HEADS
GLA_K_DIM = GLA_V_DIM // 2
GLA_GATE_RANK = 16
GLA_GATE_NORMALIZER = 16.0
GLA_CHUNK = 64
Q_BLOCK = 128
EPS = 1e-6

DIFF_QK_COLS = DIFF_HEADS * 2 * DIFF_QK_DIM
GLA_QK_COLS = GLA_HEADS * GLA_K_DIM
IN_SIZES = (
    DIFF_QK_COLS,
    DIFF_QK_COLS,
    DIFF_WIDTH,
    DIFF_WIDTH,
    GLA_QK_COLS,
    GLA_QK_COLS,
    GLA_WIDTH,
    GLA_WIDTH,
    GLA_GATE_RANK,
)
IN_COLS = sum(IN_SIZES)

kernel_name = "hymba_diffattn_gla_hybrid"


def rms_norm(x, w):
    xf = x.astype(jnp.float32)
    y = xf * lax.rsqrt(jnp.mean(xf * xf, axis=-1, keepdims=True) + EPS)
    return (y * w.astype(jnp.float32)).astype(x.dtype)


def lambda_init(layer_idx):
    return 0.8 - 0.6 * math.exp(-0.3 * layer_idx)


def alibi_slopes(n_heads):
    return jnp.exp2(-8.0 * jnp.arange(1, n_heads + 1, dtype=jnp.float32) / n_heads)


def diff_attention(q, k, v, lam, slopes):
    B, H, _, T, d = q.shape
    nb = T // Q_BLOCK
    scale = d ** -0.5
    qf = q.astype(jnp.float32) * scale
    kf = k.astype(jnp.float32)
    vf = v.astype(jnp.float32)
    q_blocks = jnp.moveaxis(qf.reshape(B, H, 2, nb, Q_BLOCK, d), 3, 0)
    key_pos = jnp.arange(T, dtype=jnp.int32)

    def one_block(args):
        q_blk, blk = args
        q_pos = blk * Q_BLOCK + jnp.arange(Q_BLOCK, dtype=jnp.int32)
        dist = q_pos[:, None] - key_pos[None, :]
        bias = -slopes[:, None, None] * dist.astype(jnp.float32)
        s = jnp.einsum('bhiqd,bhikd->bhiqk', q_blk, kf) + bias[None, :, None]
        s = jnp.where(dist[None, None, None] >= 0, s, -jnp.inf)
        p = jax.nn.softmax(s, axis=-1)
        p_diff = p[:, :, 0] - lam * p[:, :, 1]
        return jnp.einsum('bhqk,bhkd->bhqd', p_diff, vf)

    out = lax.map(one_block, (q_blocks, jnp.arange(nb, dtype=jnp.int32)))
    return jnp.moveaxis(out, 0, 2).reshape(B, H, T, v.shape[-1]).astype(v.dtype)


def gla_chunked(q, k, v, g):
    B, H, T, dk = q.shape
    dv = v.shape[-1]
    C = GLA_CHUNK
    N = T // C
    qf = (q.astype(jnp.float32) * dk ** -0.5).reshape(B, H, N, C, dk)
    kf = k.astype(jnp.float32).reshape(B, H, N, C, dk)
    vf = v.astype(jnp.float32).reshape(B, H, N, C, dv)
    b = jnp.cumsum(g.astype(jnp.float32).reshape(B, H, N, C, dk), axis=3)
    b_last = b[:, :, :, -1:]
    q_in = qf * jnp.exp(b)
    k_in = kf * jnp.exp(-b)
    k_state = kf * jnp.exp(b_last - b)
    causal = jnp.tril(jnp.ones((C, C), dtype=bool))
    a = jnp.einsum('bhncd,bhnsd->bhncs', q_in, k_in)
    a = jnp.where(causal, a, 0.0)
    o_intra = jnp.einsum('bhncs,bhnse->bhnce', a, vf)
    kv = jnp.einsum('bhncd,bhnce->bhnde', k_state, vf)
    decay = jnp.exp(b_last[:, :, :, 0])

    def step(state, inp):
        kv_n, dec_n = inp
        return state * dec_n[..., None] + kv_n, state

    s0 = jnp.zeros((B, H, dk, dv), jnp.float32)
    _, s_prev = lax.scan(step, s0, (jnp.moveaxis(kv, 2, 0), jnp.moveaxis(decay, 2, 0)))
    s_prev = jnp.moveaxis(s_prev, 0, 2)
    o_inter = jnp.einsum('bhncd,bhnde->bhnce', q_in, s_prev)
    return (o_intra + o_inter).reshape(B, H, T, dv).astype(v.dtype)


def hybrid_layer(x, norm_w, w_in, w_gate_up, b_gate, lq1, lk1, lq2, lk2,
                 diff_subln_w, gla_norm_w, w_out, layer_idx):
    B, T, _ = x.shape
    h = rms_norm(x, norm_w)
    proj = jnp.einsum('btd,de->bte', h, w_in)
    split_points = []
    acc = 0
    for s in IN_SIZES[:-1]:
        acc += s
        split_points.append(acc)
    dq, dk, dv, dg, gq, gk, gv, gg, ga = jnp.split(proj, split_points, axis=-1)

    q_a = dq.reshape(B, T, DIFF_HEADS, 2, DIFF_QK_DIM).transpose(0, 2, 3, 1, 4)
    k_a = dk.reshape(B, T, DIFF_HEADS, 2, DIFF_QK_DIM).transpose(0, 2, 3, 1, 4)
    v_a = dv.reshape(B, T, DIFF_HEADS, DIFF_V_DIM).transpose(0, 2, 1, 3)
    lam_init = lambda_init(layer_idx)
    lam = (jnp.exp(jnp.sum(lq1.astype(jnp.float32) * lk1.astype(jnp.float32)))
           - jnp.exp(jnp.sum(lq2.astype(jnp.float32) * lk2.astype(jnp.float32)))
           + lam_init)
    o_a = diff_attention(q_a, k_a, v_a, lam, alibi_slopes(DIFF_HEADS))
    o_a = rms_norm(o_a, diff_subln_w) * (1.0 - lam_init)
    o_a = o_a.transpose(0, 2, 1, 3).reshape(B, T, DIFF_WIDTH) * jax.nn.silu(dg)

    q_b = gq.reshape(B, T, GLA_HEADS, GLA_K_DIM).transpose(0, 2, 1, 3)
    k_b = gk.reshape(B, T, GLA_HEADS, GLA_K_DIM).transpose(0, 2, 1, 3)
    v_b = gv.reshape(B, T, GLA_HEADS, GLA_V_DIM).transpose(0, 2, 1, 3)
    g_logit = jnp.einsum('btr,rk->btk', ga, w_gate_up) + b_gate
    g_log = jax.nn.log_sigmoid(g_logit.astype(jnp.float32)) / GLA_GATE_NORMALIZER
    g_b = g_log.reshape(B, T, GLA_HEADS, GLA_K_DIM).transpose(0, 2, 1, 3)
    o_b = gla_chunked(q_b, k_b, v_b, g_b)
    o_b = rms_norm(o_b, gla_norm_w)
    o_b = o_b.transpose(0, 2, 1, 3).reshape(B, T, GLA_WIDTH) * jax.nn.silu(gg)

    y = jnp.concatenate([o_a, o_b], axis=-1)
    return x + jnp.einsum('btm,md->btd', y, w_out)


def setup_inputs(seed: int = 0) -> dict:
    key = jax.random.key(seed)
    ks = jax.random.split(key, 16)
    f32 = jnp.float32
    x = jax.random.normal(ks[0], (BATCH, SEQ, D_MODEL), f32)
    norm_w = 1.0 + 0.01 * jax.random.normal(ks[1], (DEPTH, D_MODEL), f32)
    w_in = jax.random.normal(ks[2], (DEPTH, D_MODEL, IN_COLS), f32) * D_MODEL ** -0.5
    w_gate_up = jax.random.normal(ks[3], (DEPTH, GLA_GATE_RANK, GLA_QK_COLS), f32) * GLA_GATE_RANK ** -0.5
    b_gate = 0.1 * jax.random.normal(ks[4], (DEPTH, GLA_QK_COLS), f32)
    lambda_q1 = 0.1 * jax.random.normal(ks[5], (DEPTH, DIFF_QK_DIM), f32)
    lambda_k1 = 0.1 * jax.random.normal(ks[6], (DEPTH, DIFF_QK_DIM), f32)
    lambda_q2 = 0.1 * jax.random.normal(ks[7], (DEPTH, DIFF_QK_DIM), f32)
    lambda_k2 = 0.1 * jax.random.normal(ks[8], (DEPTH, DIFF_QK_DIM), f32)
    diff_subln_w = 1.0 + 0.01 * jax.random.normal(ks[9], (DEPTH, DIFF_V_DIM), f32)
    gla_norm_w = 1.0 + 0.01 * jax.random.normal(ks[10], (DEPTH, GLA_V_DIM), f32)
    w_out = jax.random.normal(ks[11], (DEPTH, D_MIX, D_MODEL), f32) * D_MIX ** -0.5
    final_norm_w = 1.0 + 0.01 * jax.random.normal(ks[12], (D_MODEL,), f32)
    return {"x": x, "norm_w": norm_w, "w_in": w_in, "w_gate_up": w_gate_up,
            "b_gate": b_gate, "lambda_q1": lambda_q1, "lambda_k1": lambda_k1,
            "lambda_q2": lambda_q2, "lambda_k2": lambda_k2,
            "diff_subln_w": diff_subln_w, "gla_norm_w": gla_norm_w,
            "w_out": w_out, "final_norm_w": final_norm_w}


def reference(x, norm_w, w_in, w_gate_up, b_gate, lambda_q1, lambda_k1, lambda_q2,
              lambda_k2, diff_subln_w, gla_norm_w, w_out, final_norm_w):
    h = x
    for layer in range(DEPTH):
        h = hybrid_layer(h, norm_w[layer], w_in[layer], w_gate_up[layer], b_gate[layer],
                         lambda_q1[layer], lambda_k1[layer], lambda_q2[layer], lambda_k2[layer],
                         diff_subln_w[layer], gla_norm_w[layer], w_out[layer], layer)
    return rms_norm(h, final_norm_w)
```

```cpp
#include <hip/hip_runtime.h>
#include <cstdio>
#include <cstdint>

#ifndef MK_N_LAUNCHES
#define MK_N_LAUNCHES 6
#endif
constexpr int N_LAUNCHES = MK_N_LAUNCHES;
constexpr int PER_PHASE = 6;
constexpr int NWAVES = 8;

constexpr int BATCH = 8, T = 8192, D = 1024, M = BATCH * T;
constexpr int H = 4;
constexpr int IN_COLS = 3600;
constexpr int NP = 3840;
constexpr float EPS = 1e-6f;
constexpr float LOG2E = 1.4426950408889634f;
constexpr float C2 = 0.125f * LOG2E;
constexpr float LAM_INIT = 0.2f;

constexpr size_t MiB = 1u << 20;
constexpr size_t WS_CTL = 0, CTL_ZERO_BYTES = 1 * MiB;
constexpr size_t WS_WIN = 2 * MiB;
constexpr size_t WS_WOUT = 10 * MiB;
constexpr size_t WS_GST = 16 * MiB;
constexpr size_t WS_XN = 32 * MiB;
constexpr size_t WS_Y = 160 * MiB;
constexpr size_t WS_QA = 288 * MiB, WS_KA = 352 * MiB, WS_VA = 416 * MiB, WS_SGA = 480 * MiB;
constexpr size_t WS_QB = 544 * MiB, WS_KB = 576 * MiB;
constexpr size_t WS_VB = 608 * MiB, WS_SGB = 672 * MiB;
constexpr size_t WS_G = 736 * MiB;
constexpr size_t WS_O1 = 800 * MiB;
constexpr size_t WS_END = 928 * MiB;
constexpr int CW_TMO = 0, CW_CODE = 1, CW_BAR = 4096;

constexpr int RING_BYTES = 147456;
constexpr int LDSCTL_OFF = RING_BYTES, MISC_OFF = LDSCTL_OFF + 320;
constexpr int LDS_BYTES = RING_BYTES + 1024;

#define GAS __attribute__((address_space(1)))
#define LAS __attribute__((address_space(3)))
typedef unsigned short bf16;
typedef unsigned v4u __attribute__((ext_vector_type(4)));
typedef float f32x4 __attribute__((ext_vector_type(4)));
typedef GAS unsigned gu32;
#define RLX_AGENT __ATOMIC_RELAXED, __HIP_MEMORY_SCOPE_AGENT
#define LDS_WAIT() asm volatile("s_waitcnt lgkmcnt(0)" ::: "memory")
#define VM_WAIT() asm volatile("s_waitcnt vmcnt(0)" ::: "memory")

__device__ __forceinline__ unsigned f2bf(float f) { unsigned u = __builtin_bit_cast(unsigned, f); return (u + 0x7fffu + ((u >> 16) & 1u)) >> 16; }
__device__ __forceinline__ unsigned pk2(float lo, float hi) { return f2bf(lo) | (f2bf(hi) << 16); }
__device__ __forceinline__ float bf2f(unsigned short b) { return __builtin_bit_cast(float, (unsigned)b << 16); }
__device__ __forceinline__ float bflo(unsigned w) { return __builtin_bit_cast(float, w << 16); }
__device__ __forceinline__ float bfhi(unsigned w) { return __builtin_bit_cast(float, w & 0xffff0000u); }
__device__ __forceinline__ float silu_f(float v) { return v / (1.f + __expf(-v)); }
__device__ __forceinline__ float logsigmoid_f(float v) { return fminf(v, 0.f) - log1pf(__expf(-fabsf(v))); }

#define XB_TMO      128
#define XB_XCNT(j)  (256  + 64 * (j))
#define XB_XSUB(j)  (1280 + 64 * (j))
#define XB_XGEN(j)  (2304 + 64 * (j))
#define XB_TOP      3328
#define XB_TOPGEN   3392
#define XCD_BAR_WORDS 3456
#define XB_SPIN_CAP (1u << 22)
__device__ __forceinline__ unsigned xb_ld(unsigned* p)              { return __hip_atomic_load(p, __ATOMIC_RELAXED, __HIP_MEMORY_SCOPE_AGENT); }
__device__ __forceinline__ unsigned xb_add(unsigned* p, unsigned v) { return __hip_atomic_fetch_add(p, v, __ATOMIC_RELAXED, __HIP_MEMORY_SCOPE_AGENT); }
__device__ __forceinline__ unsigned xb_xcc_id() { return (unsigned)__builtin_amdgcn_s_getreg((3 << 11) | 20) & 0xFu; }
#define XB_SPIN(cond, bar) do { unsigned _sp = 0; while (cond) { __builtin_amdgcn_s_sleep(1); \
    if ((++_sp & 255u) == 0u) { if (xb_ld(&(bar)[XB_TMO])) break; if (_sp > XB_SPIN_CAP) { atomicAdd(&(bar)[XB_TMO], 1u); break; } } } } while (0)
struct XcdBarrier { unsigned* bar; unsigned x; volatile LAS unsigned* st; };
__device__ __forceinline__ XcdBarrier xcd_barrier_post(unsigned* bar, volatile LAS unsigned* st) {
    XcdBarrier b; b.bar = bar; b.x = xb_xcc_id(); b.st = st;
    if (threadIdx.x == 0) (void)xb_add(&bar[XB_XCNT(b.x)], 1u);
    return b;
}
__device__ __forceinline__ void xcd_barrier_complete(unsigned* bar, unsigned x, unsigned& nloc, unsigned& nx) {
    const unsigned G = gridDim.x * gridDim.y * gridDim.z;
    unsigned sum, cnt, mine, sp = 0u;
    for (;;) {
        sum = 0u; cnt = 0u; mine = 0u;
#pragma unroll
        for (unsigned j = 0; j < 16; ++j) { const unsigned c = xb_ld(&bar[XB_XCNT(j)]); sum += c; cnt += (c > 0u) ? 1u : 0u; mine = (j == x) ? c : mine; }
        if (sum == G) break;
        __builtin_amdgcn_s_sleep(1);
        if ((++sp & 255u) == 0u) { if (xb_ld(&bar[XB_TMO])) break; if (sp > XB_SPIN_CAP) { atomicAdd(&bar[XB_TMO], 1u); break; } }
    }
    nloc = mine > 0u ? mine : 1u; nx = cnt > 0u ? cnt : 1u;
}
__device__ __forceinline__ void xcd_barrier(const XcdBarrier& b) {
    asm volatile("s_waitcnt vmcnt(0)" ::: "memory");
    __syncthreads();
    if (threadIdx.x == 0) {
        unsigned* bar = b.bar;
        __builtin_amdgcn_s_waitcnt(0);
        unsigned nloc = b.st[0], nx = b.st[1];
        if (nloc == 0u) { xcd_barrier_complete(bar, b.x, nloc, nx); b.st[0] = nloc; b.st[1] = nx; }
        const unsigned old = xb_add(&bar[XB_XSUB(b.x)], 1u);
        const unsigned gen = old / nloc;
        if (old + 1u == (gen + 1u) * nloc) {
            __builtin_amdgcn_fence(__ATOMIC_RELEASE, "agent");
            asm volatile("s_waitcnt vmcnt(0)" ::: "memory");
            const unsigned og = xb_add(&bar[XB_TOP], 1u);
            const unsigned tg = og / nx;
            if (og + 1u == (tg + 1u) * nx) xb_add(&bar[XB_TOPGEN], 1u);
            else XB_SPIN(xb_ld(&bar[XB_TOPGEN]) == tg, bar);
            __builtin_amdgcn_fence(__ATOMIC_ACQUIRE, "agent");
            xb_add(&bar[XB_XGEN(b.x)], 1u);
            asm volatile("s_waitcnt vmcnt(0)" ::: "memory");
        } else {
            XB_SPIN(xb_ld(&bar[XB_XGEN(b.x)]) == gen, bar);
            __builtin_amdgcn_fence(__ATOMIC_ACQUIRE, "agent");
            asm volatile("s_waitcnt vmcnt(0)" ::: "memory");
        }
    }
    __syncthreads();
}

struct Frame {
    LAS unsigned char* lds;
    volatile LAS unsigned* MISC;
    gu32* ctl;
    int tid, lane, wave, vcu, G;
    const float *x, *norm_w, *w_in, *w_gate_up, *b_gate, *lq1, *lk1, *lq2, *lk2, *subln_w, *gla_w, *w_out, *fin_w;
    float* out;
    bf16 *Win_t, *Wout_t, *XN, *Y, *QA, *KA, *VA, *SGA, *QB, *KB, *VB, *SGB;
    float *Gg, *O1, *GST;
};
__device__ __forceinline__ float wave_sum(float v) {
#pragma unroll
    for (int o = 1; o < 64; o <<= 1) v += __shfl_xor(v, o);
    return v;
}

__device__ __forceinline__ void p0_transpose_item(const float* W, int K, int ldw, int nblk, const float* ks, bf16* WT, int row_off, LAS float* scr, int item, int lane) {
    const int kb = item / nblk, nb = item % nblk, k0 = 64 * kb, n0 = 32 * nb;
#pragma unroll 8
    for (int i = 0; i < 32; ++i) { const int kk = 2 * i + (lane >> 5); float v = W[(size_t)(k0 + kk) * ldw + n0 + (lane & 31)]; if (ks) v *= ks[k0 + kk]; scr[kk * 33 + (lane & 31)] = v; }
    LDS_WAIT(); asm volatile("" ::: "memory");
    const int c = lane & 7;
#pragma unroll
    for (int j = 0; j < 4; ++j) { const int n = (lane >> 3) + 8 * j; const LAS float* s = scr + (8 * c) * 33 + n;
        v4u o; o.x = pk2(s[0 * 33], s[1 * 33]); o.y = pk2(s[2 * 33], s[3 * 33]); o.z = pk2(s[4 * 33], s[5 * 33]); o.w = pk2(s[6 * 33], s[7 * 33]);
        *(GAS v4u*)(WT + (size_t)(row_off + n0 + n) * K + k0 + 8 * c) = o; }
    LDS_WAIT(); asm volatile("" ::: "memory");
}
__device__ __forceinline__ void rms_row_to_bf16(Frame& F, const float* xrow, bf16* orow) {
    const GAS f32x4* xr = (const GAS f32x4*)xrow + F.lane;
    f32x4 v[4]; float s = 0.f;
#pragma unroll
    for (int j = 0; j < 4; ++j) { v[j] = xr[64 * j]; s += (v[j].x * v[j].x + v[j].y * v[j].y) + (v[j].z * v[j].z + v[j].w * v[j].w); }
    const float rstd = 1.f / sqrtf(wave_sum(s) * (1.f / D) + EPS);
    GAS unsigned long long* o8 = (GAS unsigned long long*)orow + F.lane;
#pragma unroll
    for (int j = 0; j < 4; ++j) o8[64 * j] = (unsigned long long)pk2(v[j].x * rstd, v[j].y * rstd) | ((unsigned long long)pk2(v[j].z * rstd, v[j].w * rstd) << 32);
}
__device__ __forceinline__ void p0_prologue(Frame& F) {
    LAS float* scr = (LAS float*)(F.lds + F.wave * 16384);
    const int gw = F.vcu * NWAVES + F.wave, NGW = F.G * NWAVES;
    constexpr int I_IN = (D / 64) * (3584 / 32), I_OUT = (D / 64) * (D / 32);
    for (int it = gw; it < I_IN + I_OUT; it += NGW) {
        if (it < I_IN) p0_transpose_item(F.w_in, D, IN_COLS, 3584 / 32, F.norm_w, F.Win_t, 0, scr, it, F.lane);
        else p0_transpose_item(F.w_out, D, D, D / 32, nullptr, F.Wout_t, 0, scr, it - I_IN, F.lane);
    }
    const int gt = (F.vcu * NWAVES + F.wave) * 64 + F.lane, NGT = NGW * 64;
    for (int it = gt; it < 256 * (D / 8); it += NGT) {
        const int j = it / (D / 8), k0 = (it % (D / 8)) * 8;
        float wg[16];
#pragma unroll
        for (int r = 0; r < 16; ++r) wg[r] = F.w_gate_up[r * 256 + j];
        float o[8];
#pragma unroll
        for (int i = 0; i < 8; ++i) { const float* wr = F.w_in + (size_t)(k0 + i) * IN_COLS + 3584; float a = 0.f;
#pragma unroll
            for (int r = 0; r < 16; ++r) a += wr[r] * wg[r];
            o[i] = a * F.norm_w[k0 + i]; }
        v4u w; w.x = pk2(o[0], o[1]); w.y = pk2(o[2], o[3]); w.z = pk2(o[4], o[5]); w.w = pk2(o[6], o[7]);
        *(GAS v4u*)(F.Win_t + (size_t)(3584 + j) * D + k0) = w;
    }
    for (int m = gw; m < M; m += NGW) rms_row_to_bf16(F, F.x + (size_t)m * D, F.XN + (size_t)m * D);
}

struct EpiProj {
    bf16 *QA, *KA, *VA, *SGA, *QB, *KB, *VB, *SGB; float* Gg; const float* b_gate;
    __device__ __forceinline__ void operator()(int row, int col, float v) const {
        const size_t r = (size_t)row;
        if (col < 512) QA[r * 512 + col] = (bf16)f2bf(v * C2);
        else if (col < 1024) KA[r * 512 + col - 512] = (bf16)f2bf(v);
        else if (col < 1536) VA[r * 512 + col - 1024] = (bf16)f2bf(v);
        else if (col < 2048) SGA[r * 512 + col - 1536] = (bf16)f2bf(silu_f(v));
        else if (col < 2304) QB[r * 256 + col - 2048] = (bf16)f2bf(v * 0.125f);
        else if (col < 2560) KB[r * 256 + col - 2304] = (bf16)f2bf(v);
        else if (col < 3072) VB[r * 512 + col - 2560] = (bf16)f2bf(v);
        else if (col < 3584) SGB[r * 512 + col - 3072] = (bf16)f2bf(silu_f(v));
        else Gg[r * 256 + col - 3584] = logsigmoid_f(v + b_gate[col - 3584]) * (1.f / 16.f);
    }
};
struct EpiRes {
    const float* x; float* out;
    __device__ __forceinline__ void operator()(int row, int col, float v) const { const size_t i = (size_t)row * D + col; out[i] = x[i] + v; }
};
template <class Epi>
__device__ __forceinline__ void simple_gemm(Frame& F, const bf16* A, const bf16* Bt, int Mr, int N, int K, const Epi& E) {
    LAS float* As = (LAS float*)F.lds; LAS float* Bs = As + 128 * 33;
    const int tid = F.tid, ty = tid >> 4, tx = tid & 15;
    const int ntn = N / 64, ntiles = (Mr / 128) * ntn;
    for (int t = blockIdx.x; t < ntiles; t += gridDim.x) {
        const int tm = t / ntn, tn = t % ntn;
        float acc[4][4];
#pragma unroll
        for (int i = 0; i < 4; ++i)
#pragma unroll
            for (int j = 0; j < 4; ++j) acc[i][j] = 0.f;
        for (int k0 = 0; k0 < K; k0 += 32) {
            __syncthreads();
            { const int r = tid >> 2, ks = (tid & 3) * 8; const v4u w = *(const GAS v4u*)(A + (size_t)(tm * 128 + r) * K + k0 + ks);
              LAS float* d = As + r * 33 + ks; d[0] = bflo(w.x); d[1] = bfhi(w.x); d[2] = bflo(w.y); d[3] = bfhi(w.y); d[4] = bflo(w.z); d[5] = bfhi(w.z); d[6] = bflo(w.w); d[7] = bfhi(w.w); }
            if (tid < 256) { const int r = tid >> 2, ks = (tid & 3) * 8; const v4u w = *(const GAS v4u*)(Bt + (size_t)(tn * 64 + r) * K + k0 + ks);
              LAS float* d = Bs + r * 33 + ks; d[0] = bflo(w.x); d[1] = bfhi(w.x); d[2] = bflo(w.y); d[3] = bfhi(w.y); d[4] = bflo(w.z); d[5] = bfhi(w.z); d[6] = bflo(w.w); d[7] = bfhi(w.w); }
            __syncthreads();
#pragma unroll 8
            for (int kk = 0; kk < 32; ++kk) {
                float a[4], b[4];
#pragma unroll
                for (int i = 0; i < 4; ++i) { a[i] = As[(4 * ty + i) * 33 + kk]; b[i] = Bs[(4 * tx + i) * 33 + kk]; }
#pragma unroll
                for (int i = 0; i < 4; ++i)
#pragma unroll
                    for (int j = 0; j < 4; ++j) acc[i][j] += a[i] * b[j];
            }
        }
#pragma unroll
        for (int i = 0; i < 4; ++i)
#pragma unroll
            for (int j = 0; j < 4; ++j) E(tm * 128 + 4 * ty + i, tn * 64 + 4 * tx + j, acc[i][j]);
    }
    __syncthreads();
}

__device__ __forceinline__ float lambda_full(Frame& F) {
    float s1 = 0.f, s2 = 0.f;
    for (int i = 0; i < 64; ++i) { s1 += F.lq1[i] * F.lk1[i]; s2 += F.lq2[i] * F.lk2[i]; }
    return __expf(s1) - __expf(s2) + LAM_INIT;
}
__device__ __forceinline__ void simple_attn(Frame& F) {
    LAS float* Ks = (LAS float*)F.lds;
    LAS float* Vs = Ks + 64 * 64;
    const int tid = F.tid;
    const float lam = lambda_full(F);
    for (int u = blockIdx.x; u < 256; u += gridDim.x) {
        const int b = u >> 5, h = (u >> 3) & 3, p = u & 7;
        const float slope2 = exp2f(-2.f * (float)(h + 1)) * LOG2E;
        for (int half = 0; half < 2; ++half) {
            const int rb = half ? 15 - p : p;
            const int row = rb * 512 + tid;
            const size_t grow = (size_t)b * T + row;
            const int ntiles = (rb * 512 + 512) / 64;
            float ssq = 0.f;
            float* o1 = F.O1 + grow * 512 + h * 128;
            for (int pass = 0; pass < 4; ++pass) {
                const int sub = pass >> 1, eh = pass & 1;
                unsigned qw[32];
                { const GAS v4u* qp = (const GAS v4u*)(F.QA + grow * 512 + h * 128 + sub * 64);
#pragma unroll
                  for (int i = 0; i < 8; ++i) { const v4u w = qp[i]; qw[4 * i] = w.x; qw[4 * i + 1] = w.y; qw[4 * i + 2] = w.z; qw[4 * i + 3] = w.w; } }
                float mx = -1e30f, l = 0.f; float o[64];
#pragma unroll
                for (int e = 0; e < 64; ++e) o[e] = 0.f;
                for (int kt = 0; kt < ntiles; ++kt) {
                    __syncthreads();
                    { const int key = tid >> 3, seg = (tid & 7) * 8; const size_t kr = (size_t)b * T + kt * 64 + key;
                      const v4u w = *(const GAS v4u*)(F.KA + kr * 512 + h * 128 + sub * 64 + seg);
                      LAS float* d = Ks + key * 64 + seg; d[0] = bflo(w.x); d[1] = bfhi(w.x); d[2] = bflo(w.y); d[3] = bfhi(w.y); d[4] = bflo(w.z); d[5] = bfhi(w.z); d[6] = bflo(w.w); d[7] = bfhi(w.w);
                      const v4u x = *(const GAS v4u*)(F.VA + kr * 512 + h * 128 + eh * 64 + seg);
                      LAS float* e = Vs + key * 64 + seg; e[0] = bflo(x.x); e[1] = bfhi(x.x); e[2] = bflo(x.y); e[3] = bfhi(x.y); e[4] = bflo(x.z); e[5] = bfhi(x.z); e[6] = bflo(x.w); e[7] = bfhi(x.w); }
                    __syncthreads();
                    const int jn = row - kt * 64;
                    for (int j = 0; j < 64; ++j) {
                        if (j > jn) break;
                        float s = 0.f;
#pragma unroll
                        for (int dd = 0; dd < 32; ++dd) { s += bflo(qw[dd]) * Ks[j * 64 + 2 * dd]; s += bfhi(qw[dd]) * Ks[j * 64 + 2 * dd + 1]; }
                        s -= slope2 * (float)(jn - j);
                        if (s > mx) { const float al = exp2f(mx - s); l *= al;
#pragma unroll
                            for (int e = 0; e < 64; ++e) o[e] *= al;
                            mx = s; }
                        const float pp = exp2f(s - mx); l += pp;
#pragma unroll
                        for (int e = 0; e < 64; ++e) o[e] += pp * Vs[j * 64 + e];
                    }
                }
                const float rl = 1.f / l;
                if (sub == 0) {
#pragma unroll
                    for (int e = 0; e < 64; e += 4) *(GAS f32x4*)(o1 + eh * 64 + e) = (f32x4){o[e] * rl, o[e + 1] * rl, o[e + 2] * rl, o[e + 3] * rl};
                } else {
#pragma unroll
                    for (int e = 0; e < 64; e += 4) { const f32x4 a = *(const GAS f32x4*)(o1 + eh * 64 + e);
                        const f32x4 dv = (f32x4){a.x - lam * o[e] * rl, a.y - lam * o[e + 1] * rl, a.z - lam * o[e + 2] * rl, a.w - lam * o[e + 3] * rl};
                        ssq += (dv.x * dv.x + dv.y * dv.y) + (dv.z * dv.z + dv.w * dv.w);
                        *(GAS f32x4*)(o1 + eh * 64 + e) = dv; }
                }
            }
            {
                const float rstd = (1.f - LAM_INIT) / sqrtf(ssq * (1.f / 128.f) + EPS);
                const bf16* sg = F.SGA + grow * 512 + h * 128; bf16* y = F.Y + grow * 1024 + h * 128;
                for (int e = 0; e < 128; e += 8) { const v4u g = *(const GAS v4u*)(sg + e); const f32x4 a0 = *(const GAS f32x4*)(o1 + e), a1 = *(const GAS f32x4*)(o1 + e + 4); v4u w;
                    w.x = pk2(a0.x * rstd * F.subln_w[e] * bflo(g.x), a0.y * rstd * F.subln_w[e + 1] * bfhi(g.x));
                    w.y = pk2(a0.z * rstd * F.subln_w[e + 2] * bflo(g.y), a0.w * rstd * F.subln_w[e + 3] * bfhi(g.y));
                    w.z = pk2(a1.x * rstd * F.subln_w[e + 4] * bflo(g.z), a1.y * rstd * F.subln_w[e + 5] * bfhi(g.z));
                    w.w = pk2(a1.z * rstd * F.subln_w[e + 6] * bflo(g.w), a1.w * rstd * F.subln_w[e + 7] * bfhi(g.w));
                    *(GAS v4u*)(y + e) = w; }
            }
        }
    }
    __syncthreads();
}

__device__ __forceinline__ void simple_gla(Frame& F) {
    LAS float* S = (LAS float*)F.lds;
    LAS float* Qi = S + 8192;
    LAS float* Ki = Qi + 4096;
    LAS float* Kst = Ki + 4096;
    LAS float* Vv = Kst + 4096;
    LAS float* Aa = Vv + 8192;
    LAS float* wtot = Aa + 4096;
    LAS float* dec = wtot + 512;
    const int tid = F.tid, d = tid & 63, w = tid >> 6;
    for (int u = blockIdx.x; u < BATCH * H; u += gridDim.x) {
        const int b = u / H, h = u % H;
        __syncthreads();
        for (int i = tid; i < 8192; i += 512) S[i] = 0.f;
        for (int n = 0; n < T / 64; ++n) {
            const size_t tok0 = (size_t)b * T + n * 64;
            float gl[8]; float run = 0.f;
#pragma unroll
            for (int i = 0; i < 8; ++i) { run += F.Gg[(tok0 + 8 * w + i) * 256 + h * 64 + d]; gl[i] = run; }
            __syncthreads();
            wtot[w * 64 + d] = run;
            __syncthreads();
            float off = 0.f, tot = 0.f;
#pragma unroll
            for (int ww = 0; ww < 8; ++ww) { const float v = wtot[ww * 64 + d]; tot += v; if (ww < w) off += v; }
#pragma unroll
            for (int i = 0; i < 8; ++i) { const int t = 8 * w + i; const float bb = gl[i] + off;
                const float qv = bf2f(F.QB[(tok0 + t) * 256 + h * 64 + d]), kv = bf2f(F.KB[(tok0 + t) * 256 + h * 64 + d]);
                Qi[t * 64 + d] = qv * __expf(bb); Ki[t * 64 + d] = kv * __expf(-bb); Kst[t * 64 + d] = kv * __expf(tot - bb); }
            if (w == 0) dec[d] = __expf(tot);
            { const int t = tid >> 3, seg = (tid & 7) * 16;
#pragma unroll
              for (int q2 = 0; q2 < 2; ++q2) { const v4u x = *(const GAS v4u*)(F.VB + (tok0 + t) * 512 + h * 128 + seg + q2 * 8);
                LAS float* e = Vv + t * 128 + seg + q2 * 8; e[0] = bflo(x.x); e[1] = bfhi(x.x); e[2] = bflo(x.y); e[3] = bfhi(x.y); e[4] = bflo(x.z); e[5] = bfhi(x.z); e[6] = bflo(x.w); e[7] = bfhi(x.w); } }
            __syncthreads();
            { const int c = tid >> 3, s0 = (tid & 7) * 8;
#pragma unroll
              for (int si = 0; si < 8; ++si) { const int s = s0 + si; float a = 0.f;
                  for (int dd = 0; dd < 64; ++dd) a += Qi[c * 64 + dd] * Ki[s * 64 + dd];
                  Aa[c * 64 + s] = (s <= c) ? a : 0.f; } }
            __syncthreads();
            { const int c = tid >> 3, e0 = (tid & 7) * 16; float o[16];
#pragma unroll
              for (int i = 0; i < 16; ++i) o[i] = 0.f;
              for (int s = 0; s < 64; ++s) { const float a = Aa[c * 64 + s], qv = Qi[c * 64 + s];
#pragma unroll
                  for (int i = 0; i < 16; ++i) o[i] += a * Vv[s * 128 + e0 + i] + qv * S[s * 128 + e0 + i]; }
              float ssq = 0.f;
#pragma unroll
              for (int i = 0; i < 16; ++i) ssq += o[i] * o[i];
              ssq += __shfl_xor(ssq, 1); ssq += __shfl_xor(ssq, 2); ssq += __shfl_xor(ssq, 4);
              const float rstd = 1.f / sqrtf(ssq * (1.f / 128.f) + EPS);
              const bf16* sg = F.SGB + (tok0 + c) * 512 + h * 128 + e0; bf16* y = F.Y + (tok0 + c) * 1024 + 512 + h * 128 + e0;
#pragma unroll
              for (int q2 = 0; q2 < 2; ++q2) { const v4u g = *(const GAS v4u*)(sg + q2 * 8); const float* gw = F.gla_w + e0 + q2 * 8; const float* oo = o + q2 * 8; v4u wv;
                  wv.x = pk2(oo[0] * rstd * gw[0] * bflo(g.x), oo[1] * rstd * gw[1] * bfhi(g.x));
                  wv.y = pk2(oo[2] * rstd * gw[2] * bflo(g.y), oo[3] * rstd * gw[3] * bfhi(g.y));
                  wv.z = pk2(oo[4] * rstd * gw[4] * bflo(g.z), oo[5] * rstd * gw[5] * bfhi(g.z));
                  wv.w = pk2(oo[6] * rstd * gw[6] * bflo(g.w), oo[7] * rstd * gw[7] * bfhi(g.w));
                  *(GAS v4u*)(y + q2 * 8) = wv; } }
            __syncthreads();
            { const int dd = tid >> 3, e0 = (tid & 7) * 16; float a[16]; const float dc = dec[dd];
#pragma unroll
              for (int i = 0; i < 16; ++i) a[i] = dc * S[dd * 128 + e0 + i];
              for (int t = 0; t < 64; ++t) { const float kv = Kst[t * 64 + dd];
#pragma unroll
                  for (int i = 0; i < 16; ++i) a[i] += kv * Vv[t * 128 + e0 + i]; }
#pragma unroll
              for (int i = 0; i < 16; ++i) S[dd * 128 + e0 + i] = a[i]; }
        }
    }
    __syncthreads();
}

__device__ __forceinline__ void final_norm(Frame& F) {
    const int gw = F.vcu * NWAVES + F.wave, NGW = F.G * NWAVES;
    f32x4 wv[4];
#pragma unroll
    for (int j = 0; j < 4; ++j) wv[j] = ((const GAS f32x4*)F.fin_w)[F.lane + 64 * j];
    for (int m = gw; m < M; m += NGW) {
        GAS f32x4* zr = (GAS f32x4*)(F.out + (size_t)m * D) + F.lane;
        f32x4 v[4]; float s = 0.f;
#pragma unroll
        for (int j = 0; j < 4; ++j) { v[j] = zr[64 * j]; s += (v[j].x * v[j].x + v[j].y * v[j].y) + (v[j].z * v[j].z + v[j].w * v[j].w); }
        const float rstd = 1.f / sqrtf(wave_sum(s) * (1.f / D) + EPS);
#pragma unroll
        for (int j = 0; j < 4; ++j) zr[64 * j] = v[j] * rstd * wv[j];
    }
}

struct Args { const float* in[13]; float* out; unsigned char* ws; int ph_lo, ph_hi, li, pad; };
__global__ void __launch_bounds__(NWAVES * 64, 2) hybrid_fwd(Args args) {
    extern __shared__ __attribute__((aligned(16))) unsigned char lds[];
    Frame F;
    F.lds = (LAS unsigned char*)lds;
    F.MISC = (volatile LAS unsigned*)(F.lds + MISC_OFF);
    F.tid = threadIdx.x; F.lane = F.tid & 63; F.wave = __builtin_amdgcn_readfirstlane(F.tid >> 6);
    F.G = gridDim.x; { const int bx = blockIdx.x; F.vcu = (F.G % 8 == 0) ? (bx % 8) * (F.G / 8) + bx / 8 : bx; }
    unsigned char* ws = args.ws;
    F.ctl = (gu32*)(ws + WS_CTL);
    F.x = args.in[0]; F.norm_w = args.in[1]; F.w_in = args.in[2]; F.w_gate_up = args.in[3]; F.b_gate = args.in[4];
    F.lq1 = args.in[5]; F.lk1 = args.in[6]; F.lq2 = args.in[7]; F.lk2 = args.in[8]; F.subln_w = args.in[9]; F.gla_w = args.in[10];
    F.w_out = args.in[11]; F.fin_w = args.in[12]; F.out = args.out;
    F.Win_t = (bf16*)(ws + WS_WIN); F.Wout_t = (bf16*)(ws + WS_WOUT); F.XN = (bf16*)(ws + WS_XN); F.Y = (bf16*)(ws + WS_Y);
    F.QA = (bf16*)(ws + WS_QA); F.KA = (bf16*)(ws + WS_KA); F.VA = (bf16*)(ws + WS_VA); F.SGA = (bf16*)(ws + WS_SGA);
    F.QB = (bf16*)(ws + WS_QB); F.KB = (bf16*)(ws + WS_KB); F.VB = (bf16*)(ws + WS_VB); F.SGB = (bf16*)(ws + WS_SGB);
    F.Gg = (float*)(ws + WS_G); F.O1 = (float*)(ws + WS_O1); F.GST = (float*)(ws + WS_GST);
    for (int u = F.tid; u < (LDS_BYTES - LDSCTL_OFF) / 4; u += NWAVES * 64) ((LAS unsigned*)(F.lds + LDSCTL_OFF))[u] = 0u;
    __syncthreads();
    XcdBarrier bar; bar.bar = (unsigned*)(F.ctl + CW_BAR); bar.x = 0; bar.st = nullptr;
    if (N_LAUNCHES != PER_PHASE) bar = xcd_barrier_post((unsigned*)(F.ctl + CW_BAR), F.MISC + 8);
#define GRID_BAR(seam) do { if (N_LAUNCHES == PER_PHASE) { if (F.tid == 0) __hip_atomic_store(F.ctl + CW_TMO, 0xBADBA0u | (unsigned)(seam), RLX_AGENT); } else { xcd_barrier(bar); } } while (0)
    const int lo = args.ph_lo, hi = args.ph_hi;
#define IN(k) (lo <= (k) && (k) < hi)
#define BOTH(k) (IN(k) && IN((k) + 1))
    if (IN(0)) { p0_prologue(F); if (BOTH(0)) GRID_BAR(0); }
    if (IN(1)) {
        EpiProj E{F.QA, F.KA, F.VA, F.SGA, F.QB, F.KB, F.VB, F.SGB, F.Gg, F.b_gate};
        simple_gemm(F, F.XN, F.Win_t, M, NP, D, E);
        if (BOTH(1)) GRID_BAR(1);
    }
    if (IN(2)) { if (BOTH(2)) GRID_BAR(2); }
    if (IN(3)) { simple_attn(F); simple_gla(F); if (BOTH(3)) GRID_BAR(3); }
    if (IN(4)) { EpiRes E{F.x, F.out}; simple_gemm(F, F.Y, F.Wout_t, M, D, D, E); if (BOTH(4)) GRID_BAR(4); }
    if (IN(5)) { final_norm(F); }
#undef IN
#undef BOTH
}

extern "C" void kernel_launch(void* const* d_in, const int* in_sizes, int n_in, void* d_out, int out_size, void* d_ws, size_t ws_size, hipStream_t stream) {
    static int grid = 0;
    if (grid == 0) {
        if (n_in != 13 || in_sizes[0] != M * D || out_size != M * D || ws_size < WS_END) { fprintf(stderr, "kernel_launch: shape/workspace mismatch (n_in %d, in0 %d, out %d, ws %zu)\n", n_in, n_in > 0 ? in_sizes[0] : -1, out_size, ws_size); grid = -1; return; }
        int dev = 0, cus = 0, per_cu = 0;
        if (hipGetDevice(&dev) != hipSuccess || hipDeviceGetAttribute(&cus, hipDeviceAttributeMultiprocessorCount, dev) != hipSuccess) { grid = -1; return; }
        if (hipFuncSetAttribute((const void*)hybrid_fwd, hipFuncAttributeMaxDynamicSharedMemorySize, LDS_BYTES) != hipSuccess) { fprintf(stderr, "kernel_launch: hipFuncSetAttribute failed\n"); grid = -1; return; }
        if (hipOccupancyMaxActiveBlocksPerMultiprocessor(&per_cu, (const void*)hybrid_fwd, NWAVES * 64, LDS_BYTES) != hipSuccess || per_cu < 1) { fprintf(stderr, "kernel_launch: occupancy query says %d\n", per_cu); per_cu = 1; }
        (void)hipGetLastError();
        grid = cus;
    }
    if (grid < 0) return;
    (void)hipMemsetAsync((char*)d_ws + WS_CTL, 0, CTL_ZERO_BYTES, stream);
    Args a{};
    for (int i = 0; i < 13; ++i) a.in[i] = (const float*)d_in[i];
    a.out = (float*)d_out; a.ws = (unsigned char*)d_ws;
    if (N_LAUNCHES == 1) { a.ph_lo = 0; a.ph_hi = PER_PHASE; a.li = 0; hipLaunchKernelGGL(hybrid_fwd, dim3(grid), dim3(NWAVES * 64), LDS_BYTES, stream, a); }
    else for (int li = 0; li < PER_PHASE; ++li) { a.ph_lo = li; a.ph_hi = li + 1; a.li = li; hipLaunchKernelGGL(hybrid_fwd, dim3(grid), dim3(NWAVES * 64), LDS_BYTES, stream, a); }
}
```

```cpp
#include <hip/hip_runtime.h>
#include <cstdio>
#include <cstdint>

#ifndef MK_N_LAUNCHES
#define MK_N_LAUNCHES 1
#endif
constexpr int N_LAUNCHES = MK_N_LAUNCHES;
constexpr int PER_PHASE = 6;
constexpr int NWAVES = 8;

constexpr int BATCH = 8, T = 8192, D = 1024, M = BATCH * T;
constexpr int H = 4;
constexpr int IN_COLS = 3600;
constexpr int NP = 3840;
constexpr float EPS = 1e-6f;
constexpr float LOG2E = 1.4426950408889634f;
constexpr float C2 = 0.125f * LOG2E;
constexpr float LAM_INIT = 0.2f;

constexpr size_t MiB = 1u << 20;
constexpr size_t WS_CTL = 0, CTL_ZERO_BYTES = 1 * MiB;
constexpr size_t WS_WIN = 2 * MiB;
constexpr size_t WS_WOUT = 10 * MiB;
constexpr size_t WS_GST = 16 * MiB;
constexpr size_t WS_XN = 32 * MiB;
constexpr size_t WS_Y = 160 * MiB;
constexpr size_t WS_QA = 288 * MiB, WS_KA = 352 * MiB, WS_VA = 416 * MiB, WS_SGA = 480 * MiB;
constexpr size_t WS_QB = 544 * MiB, WS_KB = 576 * MiB;
constexpr size_t WS_VB = 608 * MiB, WS_SGB = 672 * MiB;
constexpr size_t WS_G = 736 * MiB;
constexpr size_t WS_O1 = 800 * MiB;
constexpr size_t WS_END = 928 * MiB;
constexpr int CW_TMO = 0, CW_CODE = 1, CW_BAR = 4096;

constexpr int RING_BYTES = 147456;
constexpr int LDSCTL_OFF = RING_BYTES, MISC_OFF = LDSCTL_OFF + 320;
constexpr int LDS_BYTES = RING_BYTES + 1024;

#define GAS __attribute__((address_space(1)))
#define LAS __attribute__((address_space(3)))
typedef unsigned short bf16;
typedef unsigned v4u __attribute__((ext_vector_type(4)));
typedef float f32x4 __attribute__((ext_vector_type(4)));
typedef GAS unsigned gu32;
#define RLX_AGENT __ATOMIC_RELAXED, __HIP_MEMORY_SCOPE_AGENT
#define LDS_WAIT() asm volatile("s_waitcnt lgkmcnt(0)" ::: "memory")
#define VM_WAIT() asm volatile("s_waitcnt vmcnt(0)" ::: "memory")

__device__ __forceinline__ unsigned f2bf(float f) { unsigned u = __builtin_bit_cast(unsigned, f); return (u + 0x7fffu + ((u >> 16) & 1u)) >> 16; }
__device__ __forceinline__ unsigned pk2(float lo, float hi) { return f2bf(lo) | (f2bf(hi) << 16); }
__device__ __forceinline__ float bf2f(unsigned short b) { return __builtin_bit_cast(float, (unsigned)b << 16); }
__device__ __forceinline__ float bflo(unsigned w) { return __builtin_bit_cast(float, w << 16); }
__device__ __forceinline__ float bfhi(unsigned w) { return __builtin_bit_cast(float, w & 0xffff0000u); }
__device__ __forceinline__ float silu_f(float v) { return v / (1.f + __expf(-v)); }
__device__ __forceinline__ float logsigmoid_f(float v) { return fminf(v, 0.f) - log1pf(__expf(-fabsf(v))); }

#define XB_TMO      128
#define XB_XCNT(j)  (256  + 64 * (j))
#define XB_XSUB(j)  (1280 + 64 * (j))
#define XB_XGEN(j)  (2304 + 64 * (j))
#define XB_TOP      3328
#define XB_TOPGEN   3392
#define XCD_BAR_WORDS 3456
#define XB_SPIN_CAP (1u << 22)
__device__ __forceinline__ unsigned xb_ld(unsigned* p)              { return __hip_atomic_load(p, __ATOMIC_RELAXED, __HIP_MEMORY_SCOPE_AGENT); }
__device__ __forceinline__ unsigned xb_add(unsigned* p, unsigned v) { return __hip_atomic_fetch_add(p, v, __ATOMIC_RELAXED, __HIP_MEMORY_SCOPE_AGENT); }
__device__ __forceinline__ unsigned xb_xcc_id() { return (unsigned)__builtin_amdgcn_s_getreg((3 << 11) | 20) & 0xFu; }
#define XB_SPIN(cond, bar) do { unsigned _sp = 0; while (cond) { __builtin_amdgcn_s_sleep(1); \
    if ((++_sp & 255u) == 0u) { if (xb_ld(&(bar)[XB_TMO])) break; if (_sp > XB_SPIN_CAP) { atomicAdd(&(bar)[XB_TMO], 1u); break; } } } } while (0)
struct XcdBarrier { unsigned* bar; unsigned x; volatile LAS unsigned* st; };
__device__ __forceinline__ XcdBarrier xcd_barrier_post(unsigned* bar, volatile LAS unsigned* st) {
    XcdBarrier b; b.bar = bar; b.x = xb_xcc_id(); b.st = st;
    if (threadIdx.x == 0) (void)xb_add(&bar[XB_XCNT(b.x)], 1u);
    return b;
}
__device__ __forceinline__ void xcd_barrier_complete(unsigned* bar, unsigned x, unsigned& nloc, unsigned& nx) {
    const unsigned G = gridDim.x * gridDim.y * gridDim.z;
    unsigned sum, cnt, mine, sp = 0u;
    for (;;) {
        sum = 0u; cnt = 0u; mine = 0u;
#pragma unroll
        for (unsigned j = 0; j < 16; ++j) { const unsigned c = xb_ld(&bar[XB_XCNT(j)]); sum += c; cnt += (c > 0u) ? 1u : 0u; mine = (j == x) ? c : mine; }
        if (sum == G) break;
        __builtin_amdgcn_s_sleep(1);
        if ((++sp & 255u) == 0u) { if (xb_ld(&bar[XB_TMO])) break; if (sp > XB_SPIN_CAP) { atomicAdd(&bar[XB_TMO], 1u); break; } }
    }
    nloc = mine > 0u ? mine : 1u; nx = cnt > 0u ? cnt : 1u;
}
__device__ __forceinline__ void xcd_barrier(const XcdBarrier& b) {
    asm volatile("s_waitcnt vmcnt(0)" ::: "memory");
    __syncthreads();
    if (threadIdx.x == 0) {
        unsigned* bar = b.bar;
        __builtin_amdgcn_s_waitcnt(0);
        unsigned nloc = b.st[0], nx = b.st[1];
        if (nloc == 0u) { xcd_barrier_complete(bar, b.x, nloc, nx); b.st[0] = nloc; b.st[1] = nx; }
        const unsigned old = xb_add(&bar[XB_XSUB(b.x)], 1u);
        const unsigned gen = old / nloc;
        if (old + 1u == (gen + 1u) * nloc) {
            __builtin_amdgcn_fence(__ATOMIC_RELEASE, "agent");
            asm volatile("s_waitcnt vmcnt(0)" ::: "memory");
            const unsigned og = xb_add(&bar[XB_TOP], 1u);
            const unsigned tg = og / nx;
            if (og + 1u == (tg + 1u) * nx) xb_add(&bar[XB_TOPGEN], 1u);
            else XB_SPIN(xb_ld(&bar[XB_TOPGEN]) == tg, bar);
            __builtin_amdgcn_fence(__ATOMIC_ACQUIRE, "agent");
            xb_add(&bar[XB_XGEN(b.x)], 1u);
            asm volatile("s_waitcnt vmcnt(0)" ::: "memory");
        } else {
            XB_SPIN(xb_ld(&bar[XB_XGEN(b.x)]) == gen, bar);
            __builtin_amdgcn_fence(__ATOMIC_ACQUIRE, "agent");
            asm volatile("s_waitcnt vmcnt(0)" ::: "memory");
        }
    }
    __syncthreads();
}

struct Frame {
    LAS unsigned char* lds;
    volatile LAS unsigned* MISC;
    gu32* ctl;
    int tid, lane, wave, vcu, G;
    const float *x, *norm_w, *w_in, *w_gate_up, *b_gate, *lq1, *lk1, *lq2, *lk2, *subln_w, *gla_w, *w_out, *fin_w;
    float* out;
    bf16 *Win_t, *Wout_t, *XN, *Y, *QA, *KA, *VA, *SGA, *QB, *KB, *VB, *SGB;
    float *Gg, *O1, *GST;
};
__device__ __forceinline__ float wave_sum(float v) {
#pragma unroll
    for (int o = 1; o < 64; o <<= 1) v += __shfl_xor(v, o);
    return v;
}

__device__ __forceinline__ void p0_transpose_item(const float* W, int K, int ldw, int nblk, const float* ks, bf16* WT, int row_off, LAS float* scr, int item, int lane) {
    const int kb = item / nblk, nb = item % nblk, k0 = 64 * kb, n0 = 32 * nb;
#pragma unroll 8
    for (int i = 0; i < 32; ++i) { const int kk = 2 * i + (lane >> 5); float v = W[(size_t)(k0 + kk) * ldw + n0 + (lane & 31)]; if (ks) v *= ks[k0 + kk]; scr[kk * 33 + (lane & 31)] = v; }
    LDS_WAIT(); asm volatile("" ::: "memory");
    const int c = lane & 7;
#pragma unroll
    for (int j = 0; j < 4; ++j) { const int n = (lane >> 3) + 8 * j; const LAS float* s = scr + (8 * c) * 33 + n;
        v4u o; o.x = pk2(s[0 * 33], s[1 * 33]); o.y = pk2(s[2 * 33], s[3 * 33]); o.z = pk2(s[4 * 33], s[5 * 33]); o.w = pk2(s[6 * 33], s[7 * 33]);
        *(GAS v4u*)(WT + (size_t)(row_off + n0 + n) * K + k0 + 8 * c) = o; }
    LDS_WAIT(); asm volatile("" ::: "memory");
}
__device__ __forceinline__ void rms_row_to_bf16(Frame& F, const float* xrow, bf16* orow) {
    const GAS f32x4* xr = (const GAS f32x4*)xrow + F.lane;
    f32x4 v[4]; float s = 0.f;
#pragma unroll
    for (int j = 0; j < 4; ++j) { v[j] = xr[64 * j]; s += (v[j].x * v[j].x + v[j].y * v[j].y) + (v[j].z * v[j].z + v[j].w * v[j].w); }
    const float rstd = 1.f / sqrtf(wave_sum(s) * (1.f / D) + EPS);
    GAS unsigned long long* o8 = (GAS unsigned long long*)orow + F.lane;
#pragma unroll
    for (int j = 0; j < 4; ++j) o8[64 * j] = (unsigned long long)pk2(v[j].x * rstd, v[j].y * rstd) | ((unsigned long long)pk2(v[j].z * rstd, v[j].w * rstd) << 32);
}
__device__ __forceinline__ void p0_prologue(Frame& F) {
    LAS float* scr = (LAS float*)(F.lds + F.wave * 16384);
    const int gw = F.vcu * NWAVES + F.wave, NGW = F.G * NWAVES;
    constexpr int I_IN = (D / 64) * (3584 / 32), I_OUT = (D / 64) * (D / 32);
    for (int it = gw; it < I_IN + I_OUT; it += NGW) {
        if (it < I_IN) p0_transpose_item(F.w_in, D, IN_COLS, 3584 / 32, F.norm_w, F.Win_t, 0, scr, it, F.lane);
        else p0_transpose_item(F.w_out, D, D, D / 32, nullptr, F.Wout_t, 0, scr, it - I_IN, F.lane);
    }
    const int gt = (F.vcu * NWAVES + F.wave) * 64 + F.lane, NGT = NGW * 64;
    for (int it = gt; it < 256 * (D / 8); it += NGT) {
        const int j = it / (D / 8), k0 = (it % (D / 8)) * 8;
        float wg[16];
#pragma unroll
        for (int r = 0; r < 16; ++r) wg[r] = F.w_gate_up[r * 256 + j];
        float o[8];
#pragma unroll
        for (int i = 0; i < 8; ++i) { const float* wr = F.w_in + (size_t)(k0 + i) * IN_COLS + 3584; float a = 0.f;
#pragma unroll
            for (int r = 0; r < 16; ++r) a += wr[r] * wg[r];
            o[i] = a * F.norm_w[k0 + i]; }
        v4u w; w.x = pk2(o[0], o[1]); w.y = pk2(o[2], o[3]); w.z = pk2(o[4], o[5]); w.w = pk2(o[6], o[7]);
        *(GAS v4u*)(F.Win_t + (size_t)(3584 + j) * D + k0) = w;
    }
    for (int m = gw; m < M; m += NGW) rms_row_to_bf16(F, F.x + (size_t)m * D, F.XN + (size_t)m * D);
}

struct EpiProj {
    bf16 *QA, *KA, *VA, *SGA, *QB, *KB, *VB, *SGB; float* Gg; const float* b_gate;
    __device__ __forceinline__ void operator()(int row, int col, float v) const {
        const size_t r = (size_t)row;
        if (col < 512) QA[r * 512 + col] = (bf16)f2bf(v * C2);
        else if (col < 1024) KA[r * 512 + col - 512] = (bf16)f2bf(v);
        else if (col < 1536) VA[r * 512 + col - 1024] = (bf16)f2bf(v);
        else if (col < 2048) SGA[r * 512 + col - 1536] = (bf16)f2bf(silu_f(v));
        else if (col < 2304) QB[r * 256 + col - 2048] = (bf16)f2bf(v * 0.125f);
        else if (col < 2560) KB[r * 256 + col - 2304] = (bf16)f2bf(v);
        else if (col < 3072) VB[r * 512 + col - 2560] = (bf16)f2bf(v);
        else if (col < 3584) SGB[r * 512 + col - 3072] = (bf16)f2bf(silu_f(v));
        else Gg[r * 256 + col - 3584] = logsigmoid_f(v + b_gate[col - 3584]) * (1.f / 16.f);
    }
};
struct EpiRes {
    const float* x; float* out;
    __device__ __forceinline__ void operator()(int row, int col, float v) const { const size_t i = (size_t)row * D + col; out[i] = x[i] + v; }
};
template <class Epi>
__device__ __forceinline__ void simple_gemm(Frame& F, const bf16* A, const bf16* Bt, int Mr, int N, int K, const Epi& E) {
    LAS float* As = (LAS float*)F.lds; LAS float* Bs = As + 128 * 33;
    const int tid = F.tid, ty = tid >> 4, tx = tid & 15;
    const int ntn = N / 64, ntiles = (Mr / 128) * ntn;
    for (int t = blockIdx.x; t < ntiles; t += gridDim.x) {
        const int tm = t / ntn, tn = t % ntn;
        float acc[4][4];
#pragma unroll
        for (int i = 0; i < 4; ++i)
#pragma unroll
            for (int j = 0; j < 4; ++j) acc[i][j] = 0.f;
        for (int k0 = 0; k0 < K; k0 += 32) {
            __syncthreads();
            { const int r = tid >> 2, ks = (tid & 3) * 8; const v4u w = *(const GAS v4u*)(A + (size_t)(tm * 128 + r) * K + k0 + ks);
              LAS float* d = As + r * 33 + ks; d[0] = bflo(w.x); d[1] = bfhi(w.x); d[2] = bflo(w.y); d[3] = bfhi(w.y); d[4] = bflo(w.z); d[5] = bfhi(w.z); d[6] = bflo(w.w); d[7] = bfhi(w.w); }
            if (tid < 256) { const int r = tid >> 2, ks = (tid & 3) * 8; const v4u w = *(const GAS v4u*)(Bt + (size_t)(tn * 64 + r) * K + k0 + ks);
              LAS float* d = Bs + r * 33 + ks; d[0] = bflo(w.x); d[1] = bfhi(w.x); d[2] = bflo(w.y); d[3] = bfhi(w.y); d[4] = bflo(w.z); d[5] = bfhi(w.z); d[6] = bflo(w.w); d[7] = bfhi(w.w); }
            __syncthreads();
#pragma unroll 8
            for (int kk = 0; kk < 32; ++kk) {
                float a[4], b[4];
#pragma unroll
                for (int i = 0; i < 4; ++i) { a[i] = As[(4 * ty + i) * 33 + kk]; b[i] = Bs[(4 * tx + i) * 33 + kk]; }
#pragma unroll
                for (int i = 0; i < 4; ++i)
#pragma unroll
                    for (int j = 0; j < 4; ++j) acc[i][j] += a[i] * b[j];
            }
        }
#pragma unroll
        for (int i = 0; i < 4; ++i)
#pragma unroll
            for (int j = 0; j < 4; ++j) E(tm * 128 + 4 * ty + i, tn * 64 + 4 * tx + j, acc[i][j]);
    }
    __syncthreads();
}

__device__ __forceinline__ float lambda_full(Frame& F) {
    float s1 = 0.f, s2 = 0.f;
    for (int i = 0; i < 64; ++i) { s1 += F.lq1[i] * F.lk1[i]; s2 += F.lq2[i] * F.lk2[i]; }
    return __expf(s1) - __expf(s2) + LAM_INIT;
}
__device__ __forceinline__ void simple_attn(Frame& F) {
    LAS float* Ks = (LAS float*)F.lds;
    LAS float* Vs = Ks + 64 * 64;
    const int tid = F.tid;
    const float lam = lambda_full(F);
    for (int u = blockIdx.x; u < 256; u += gridDim.x) {
        const int b = u >> 5, h = (u >> 3) & 3, p = u & 7;
        const float slope2 = exp2f(-2.f * (float)(h + 1)) * LOG2E;
        for (int half = 0; half < 2; ++half) {
            const int rb = half ? 15 - p : p;
            const int row = rb * 512 + tid;
            const size_t grow = (size_t)b * T + row;
            const int ntiles = (rb * 512 + 512) / 64;
            float ssq = 0.f;
            float* o1 = F.O1 + grow * 512 + h * 128;
            for (int pass = 0; pass < 4; ++pass) {
                const int sub = pass >> 1, eh = pass & 1;
                unsigned qw[32];
                { const GAS v4u* qp = (const GAS v4u*)(F.QA + grow * 512 + h * 128 + sub * 64);
#pragma unroll
                  for (int i = 0; i < 8; ++i) { const v4u w = qp[i]; qw[4 * i] = w.x; qw[4 * i + 1] = w.y; qw[4 * i + 2] = w.z; qw[4 * i + 3] = w.w; } }
                float mx = -1e30f, l = 0.f; float o[64];
#pragma unroll
                for (int e = 0; e < 64; ++e) o[e] = 0.f;
                for (int kt = 0; kt < ntiles; ++kt) {
                    __syncthreads();
                    { const int key = tid >> 3, seg = (tid & 7) * 8; const size_t kr = (size_t)b * T + kt * 64 + key;
                      const v4u w = *(const GAS v4u*)(F.KA + kr * 512 + h * 128 + sub * 64 + seg);
                      LAS float* d = Ks + key * 64 + seg; d[0] = bflo(w.x); d[1] = bfhi(w.x); d[2] = bflo(w.y); d[3] = bfhi(w.y); d[4] = bflo(w.z); d[5] = bfhi(w.z); d[6] = bflo(w.w); d[7] = bfhi(w.w);
                      const v4u x = *(const GAS v4u*)(F.VA + kr * 512 + h * 128 + eh * 64 + seg);
                      LAS float* e = Vs + key * 64 + seg; e[0] = bflo(x.x); e[1] = bfhi(x.x); e[2] = bflo(x.y); e[3] = bfhi(x.y); e[4] = bflo(x.z); e[5] = bfhi(x.z); e[6] = bflo(x.w); e[7] = bfhi(x.w); }
                    __syncthreads();
                    const int jn = row - kt * 64;
                    for (int j = 0; j < 64; ++j) {
                        if (j > jn) break;
                        float s = 0.f;
#pragma unroll
                        for (int dd = 0; dd < 32; ++dd) { s += bflo(qw[dd]) * Ks[j * 64 + 2 * dd]; s += bfhi(qw[dd]) * Ks[j * 64 + 2 * dd + 1]; }
                        s -= slope2 * (float)(jn - j);
                        if (s > mx) { const float al = exp2f(mx - s); l *= al;
#pragma unroll
                            for (int e = 0; e < 64; ++e) o[e] *= al;
                            mx = s; }
                        const float pp = exp2f(s - mx); l += pp;
#pragma unroll
                        for (int e = 0; e < 64; ++e) o[e] += pp * Vs[j * 64 + e];
                    }
                }
                const float rl = 1.f / l;
                if (sub == 0) {
#pragma unroll
                    for (int e = 0; e < 64; e += 4) *(GAS f32x4*)(o1 + eh * 64 + e) = (f32x4){o[e] * rl, o[e + 1] * rl, o[e + 2] * rl, o[e + 3] * rl};
                } else {
#pragma unroll
                    for (int e = 0; e < 64; e += 4) { const f32x4 a = *(const GAS f32x4*)(o1 + eh * 64 + e);
                        const f32x4 dv = (f32x4){a.x - lam * o[e] * rl, a.y - lam * o[e + 1] * rl, a.z - lam * o[e + 2] * rl, a.w - lam * o[e + 3] * rl};
                        ssq += (dv.x * dv.x + dv.y * dv.y) + (dv.z * dv.z + dv.w * dv.w);
                        *(GAS f32x4*)(o1 + eh * 64 + e) = dv; }
                }
            }
            {
                const float rstd = (1.f - LAM_INIT) / sqrtf(ssq * (1.f / 128.f) + EPS);
                const bf16* sg = F.SGA + grow * 512 + h * 128; bf16* y = F.Y + grow * 1024 + h * 128;
                for (int e = 0; e < 128; e += 8) { const v4u g = *(const GAS v4u*)(sg + e); const f32x4 a0 = *(const GAS f32x4*)(o1 + e), a1 = *(const GAS f32x4*)(o1 + e + 4); v4u w;
                    w.x = pk2(a0.x * rstd * F.subln_w[e] * bflo(g.x), a0.y * rstd * F.subln_w[e + 1] * bfhi(g.x));
                    w.y = pk2(a0.z * rstd * F.subln_w[e + 2] * bflo(g.y), a0.w * rstd * F.subln_w[e + 3] * bfhi(g.y));
                    w.z = pk2(a1.x * rstd * F.subln_w[e + 4] * bflo(g.z), a1.y * rstd * F.subln_w[e + 5] * bfhi(g.z));
                    w.w = pk2(a1.z * rstd * F.subln_w[e + 6] * bflo(g.w), a1.w * rstd * F.subln_w[e + 7] * bfhi(g.w));
                    *(GAS v4u*)(y + e) = w; }
            }
        }
    }
    __syncthreads();
}

__device__ __forceinline__ void simple_gla(Frame& F) {
    LAS float* S = (LAS float*)F.lds;
    LAS float* Qi = S + 8192;
    LAS float* Ki = Qi + 4096;
    LAS float* Kst = Ki + 4096;
    LAS float* Vv = Kst + 4096;
    LAS float* Aa = Vv + 8192;
    LAS float* wtot = Aa + 4096;
    LAS float* dec = wtot + 512;
    const int tid = F.tid, d = tid & 63, w = tid >> 6;
    for (int u = blockIdx.x; u < BATCH * H; u += gridDim.x) {
        const int b = u / H, h = u % H;
        __syncthreads();
        for (int i = tid; i < 8192; i += 512) S[i] = 0.f;
        for (int n = 0; n < T / 64; ++n) {
            const size_t tok0 = (size_t)b * T + n * 64;
            float gl[8]; float run = 0.f;
#pragma unroll
            for (int i = 0; i < 8; ++i) { run += F.Gg[(tok0 + 8 * w + i) * 256 + h * 64 + d]; gl[i] = run; }
            __syncthreads();
            wtot[w * 64 + d] = run;
            __syncthreads();
            float off = 0.f, tot = 0.f;
#pragma unroll
            for (int ww = 0; ww < 8; ++ww) { const float v = wtot[ww * 64 + d]; tot += v; if (ww < w) off += v; }
#pragma unroll
            for (int i = 0; i < 8; ++i) { const int t = 8 * w + i; const float bb = gl[i] + off;
                const float qv = bf2f(F.QB[(tok0 + t) * 256 + h * 64 + d]), kv = bf2f(F.KB[(tok0 + t) * 256 + h * 64 + d]);
                Qi[t * 64 + d] = qv * __expf(bb); Ki[t * 64 + d] = kv * __expf(-bb); Kst[t * 64 + d] = kv * __expf(tot - bb); }
            if (w == 0) dec[d] = __expf(tot);
            { const int t = tid >> 3, seg = (tid & 7) * 16;
#pragma unroll
              for (int q2 = 0; q2 < 2; ++q2) { const v4u x = *(const GAS v4u*)(F.VB + (tok0 + t) * 512 + h * 128 + seg + q2 * 8);
                LAS float* e = Vv + t * 128 + seg + q2 * 8; e[0] = bflo(x.x); e[1] = bfhi(x.x); e[2] = bflo(x.y); e[3] = bfhi(x.y); e[4] = bflo(x.z); e[5] = bfhi(x.z); e[6] = bflo(x.w); e[7] = bfhi(x.w); } }
            __syncthreads();
            { const int c = tid >> 3, s0 = (tid & 7) * 8;
#pragma unroll
              for (int si = 0; si < 8; ++si) { const int s = s0 + si; float a = 0.f;
                  for (int dd = 0; dd < 64; ++dd) a += Qi[c * 64 + dd] * Ki[s * 64 + dd];
                  Aa[c * 64 + s] = (s <= c) ? a : 0.f; } }
            __syncthreads();
            { const int c = tid >> 3, e0 = (tid & 7) * 16; float o[16];
#pragma unroll
              for (int i = 0; i < 16; ++i) o[i] = 0.f;
              for (int s = 0; s < 64; ++s) { const float a = Aa[c * 64 + s], qv = Qi[c * 64 + s];
#pragma unroll
                  for (int i = 0; i < 16; ++i) o[i] += a * Vv[s * 128 + e0 + i] + qv * S[s * 128 + e0 + i]; }
              float ssq = 0.f;
#pragma unroll
              for (int i = 0; i < 16; ++i) ssq += o[i] * o[i];
              ssq += __shfl_xor(ssq, 1); ssq += __shfl_xor(ssq, 2); ssq += __shfl_xor(ssq, 4);
              const float rstd = 1.f / sqrtf(ssq * (1.f / 128.f) + EPS);
              const bf16* sg = F.SGB + (tok0 + c) * 512 + h * 128 + e0; bf16* y = F.Y + (tok0 + c) * 1024 + 512 + h * 128 + e0;
#pragma unroll
              for (int q2 = 0; q2 < 2; ++q2) { const v4u g = *(const GAS v4u*)(sg + q2 * 8); const float* gw = F.gla_w + e0 + q2 * 8; const float* oo = o + q2 * 8; v4u wv;
                  wv.x = pk2(oo[0] * rstd * gw[0] * bflo(g.x), oo[1] * rstd * gw[1] * bfhi(g.x));
                  wv.y = pk2(oo[2] * rstd * gw[2] * bflo(g.y), oo[3] * rstd * gw[3] * bfhi(g.y));
                  wv.z = pk2(oo[4] * rstd * gw[4] * bflo(g.z), oo[5] * rstd * gw[5] * bfhi(g.z));
                  wv.w = pk2(oo[6] * rstd * gw[6] * bflo(g.w), oo[7] * rstd * gw[7] * bfhi(g.w));
                  *(GAS v4u*)(y + q2 * 8) = wv; } }
            __syncthreads();
            { const int dd = tid >> 3, e0 = (tid & 7) * 16; float a[16]; const float dc = dec[dd];
#pragma unroll
              for (int i = 0; i < 16; ++i) a[i] = dc * S[dd * 128 + e0 + i];
              for (int t = 0; t < 64; ++t) { const float kv = Kst[t * 64 + dd];
#pragma unroll
                  for (int i = 0; i < 16; ++i) a[i] += kv * Vv[t * 128 + e0 + i]; }
#pragma unroll
              for (int i = 0; i < 16; ++i) S[dd * 128 + e0 + i] = a[i]; }
        }
    }
    __syncthreads();
}

__device__ __forceinline__ void final_norm(Frame& F) {
    const int gw = F.vcu * NWAVES + F.wave, NGW = F.G * NWAVES;
    f32x4 wv[4];
#pragma unroll
    for (int j = 0; j < 4; ++j) wv[j] = ((const GAS f32x4*)F.fin_w)[F.lane + 64 * j];
    for (int m = gw; m < M; m += NGW) {
        GAS f32x4* zr = (GAS f32x4*)(F.out + (size_t)m * D) + F.lane;
        f32x4 v[4]; float s = 0.f;
#pragma unroll
        for (int j = 0; j < 4; ++j) { v[j] = zr[64 * j]; s += (v[j].x * v[j].x + v[j].y * v[j].y) + (v[j].z * v[j].z + v[j].w * v[j].w); }
        const float rstd = 1.f / sqrtf(wave_sum(s) * (1.f / D) + EPS);
#pragma unroll
        for (int j = 0; j < 4; ++j) zr[64 * j] = v[j] * rstd * wv[j];
    }
}

struct Args { const float* in[13]; float* out; unsigned char* ws; int ph_lo, ph_hi, li, pad; };
__global__ void __launch_bounds__(NWAVES * 64, 2) hybrid_fwd(Args args) {
    extern __shared__ __attribute__((aligned(16))) unsigned char lds[];
    Frame F;
    F.lds = (LAS unsigned char*)lds;
    F.MISC = (volatile LAS unsigned*)(F.lds + MISC_OFF);
    F.tid = threadIdx.x; F.lane = F.tid & 63; F.wave = __builtin_amdgcn_readfirstlane(F.tid >> 6);
    F.G = gridDim.x; { const int bx = blockIdx.x; F.vcu = (F.G % 8 == 0) ? (bx % 8) * (F.G / 8) + bx / 8 : bx; }
    unsigned char* ws = args.ws;
    F.ctl = (gu32*)(ws + WS_CTL);
    F.x = args.in[0]; F.norm_w = args.in[1]; F.w_in = args.in[2]; F.w_gate_up = args.in[3]; F.b_gate = args.in[4];
    F.lq1 = args.in[5]; F.lk1 = args.in[6]; F.lq2 = args.in[7]; F.lk2 = args.in[8]; F.subln_w = args.in[9]; F.gla_w = args.in[10];
    F.w_out = args.in[11]; F.fin_w = args.in[12]; F.out = args.out;
    F.Win_t = (bf16*)(ws + WS_WIN); F.Wout_t = (bf16*)(ws + WS_WOUT); F.XN = (bf16*)(ws + WS_XN); F.Y = (bf16*)(ws + WS_Y);
    F.QA = (bf16*)(ws + WS_QA); F.KA = (bf16*)(ws + WS_KA); F.VA = (bf16*)(ws + WS_VA); F.SGA = (bf16*)(ws + WS_SGA);
    F.QB = (bf16*)(ws + WS_QB); F.KB = (bf16*)(ws + WS_KB); F.VB = (bf16*)(ws + WS_VB); F.SGB = (bf16*)(ws + WS_SGB);
    F.Gg = (float*)(ws + WS_G); F.O1 = (float*)(ws + WS_O1); F.GST = (float*)(ws + WS_GST);
    for (int u = F.tid; u < (LDS_BYTES - LDSCTL_OFF) / 4; u += NWAVES * 64) ((LAS unsigned*)(F.lds + LDSCTL_OFF))[u] = 0u;
    __syncthreads();
    XcdBarrier bar; bar.bar = (unsigned*)(F.ctl + CW_BAR); bar.x = 0; bar.st = nullptr;
    if (N_LAUNCHES != PER_PHASE) bar = xcd_barrier_post((unsigned*)(F.ctl + CW_BAR), F.MISC + 8);
#define GRID_BAR(seam) do { if (N_LAUNCHES == PER_PHASE) { if (F.tid == 0) __hip_atomic_store(F.ctl + CW_TMO, 0xBADBA0u | (unsigned)(seam), RLX_AGENT); } else { xcd_barrier(bar); } } while (0)
    const int lo = args.ph_lo, hi = args.ph_hi;
#define IN(k) (lo <= (k) && (k) < hi)
#define BOTH(k) (IN(k) && IN((k) + 1))
    if (IN(0)) { p0_prologue(F); if (BOTH(0)) GRID_BAR(0); }
    if (IN(1)) {
        EpiProj E{F.QA, F.KA, F.VA, F.SGA, F.QB, F.KB, F.VB, F.SGB, F.Gg, F.b_gate};
        simple_gemm(F, F.XN, F.Win_t, M, NP, D, E);
        if (BOTH(1)) GRID_BAR(1);
    }
    if (IN(2)) { if (BOTH(2)) GRID_BAR(2); }
    if (IN(3)) { simple_attn(F); simple_gla(F); if (BOTH(3)) GRID_BAR(3); }
    if (IN(4)) { EpiRes E{F.x, F.out}; simple_gemm(F, F.Y, F.Wout_t, M, D, D, E); if (BOTH(4)) GRID_BAR(4); }
    if (IN(5)) { final_norm(F); }
#undef IN
#undef BOTH
}

extern "C" void kernel_launch(void* const* d_in, const int* in_sizes, int n_in, void* d_out, int out_size, void* d_ws, size_t ws_size, hipStream_t stream) {
    static int grid = 0;
    if (grid == 0) {
        if (n_in != 13 || in_sizes[0] != M * D || out_size != M * D || ws_size < WS_END) { fprintf(stderr, "kernel_launch: shape/workspace mismatch (n_in %d, in0 %d, out %d, ws %zu)\n", n_in, n_in > 0 ? in_sizes[0] : -1, out_size, ws_size); grid = -1; return; }
        int dev = 0, cus = 0, per_cu = 0;
        if (hipGetDevice(&dev) != hipSuccess || hipDeviceGetAttribute(&cus, hipDeviceAttributeMultiprocessorCount, dev) != hipSuccess) { grid = -1; return; }
        if (hipFuncSetAttribute((const void*)hybrid_fwd, hipFuncAttributeMaxDynamicSharedMemorySize, LDS_BYTES) != hipSuccess) { fprintf(stderr, "kernel_launch: hipFuncSetAttribute failed\n"); grid = -1; return; }
        if (hipOccupancyMaxActiveBlocksPerMultiprocessor(&per_cu, (const void*)hybrid_fwd, NWAVES * 64, LDS_BYTES) != hipSuccess || per_cu < 1) { fprintf(stderr, "kernel_launch: occupancy query says %d\n", per_cu); per_cu = 1; }
        (void)hipGetLastError();
        grid = cus;
    }
    if (grid < 0) return;
    (void)hipMemsetAsync((char*)d_ws + WS_CTL, 0, CTL_ZERO_BYTES, stream);
    Args a{};
    for (int i = 0; i < 13; ++i) a.in[i] = (const float*)d_in[i];
    a.out = (float*)d_out; a.ws = (unsigned char*)d_ws;
    if (N_LAUNCHES == 1) { a.ph_lo = 0; a.ph_hi = PER_PHASE; a.li = 0; hipLaunchKernelGGL(hybrid_fwd, dim3(grid), dim3(NWAVES * 64), LDS_BYTES, stream, a); }
    else for (int li = 0; li < PER_PHASE; ++li) { a.ph_lo = li; a.ph_hi = li + 1; a.li = li; hipLaunchKernelGGL(hybrid_fwd, dim3(grid), dim3(NWAVES * 64), LDS_BYTES, stream, a); }
}
```

```cpp
#include <hip/hip_runtime.h>
#include <cstdio>
#include <cstdint>

#ifndef MK_N_LAUNCHES
#define MK_N_LAUNCHES 1
#endif
constexpr int N_LAUNCHES = MK_N_LAUNCHES;
constexpr int PER_PHASE = 6;
constexpr int NWAVES = 8;

constexpr int BATCH = 8, T = 8192, D = 1024, M = BATCH * T;
constexpr int H = 4;
constexpr int IN_COLS = 3600;
constexpr int NP = 3840;
constexpr float EPS = 1e-6f;
constexpr float LOG2E = 1.4426950408889634f;
constexpr float C2 = 0.125f * LOG2E;
constexpr float LAM_INIT = 0.2f;

constexpr size_t MiB = 1u << 20;
constexpr size_t WS_CTL = 0, CTL_ZERO_BYTES = 1 * MiB;
constexpr size_t WS_WIN = 2 * MiB;
constexpr size_t WS_WOUT = 10 * MiB;
constexpr size_t WS_GST = 16 * MiB;
constexpr size_t WS_XN = 32 * MiB;
constexpr size_t WS_Y = 160 * MiB;
constexpr size_t WS_QA = 288 * MiB, WS_KA = 352 * MiB, WS_VA = 416 * MiB, WS_SGA = 480 * MiB;
constexpr size_t WS_QB = 544 * MiB, WS_KB = 576 * MiB;
constexpr size_t WS_VB = 608 * MiB, WS_SGB = 672 * MiB;
constexpr size_t WS_G = 736 * MiB;
constexpr size_t WS_O1 = 800 * MiB;
constexpr size_t WS_END = 928 * MiB;
constexpr int CW_TMO = 0, CW_CODE = 1, CW_BAR = 4096;

constexpr int RING_BYTES = 147456;
constexpr int LDSCTL_OFF = RING_BYTES, MISC_OFF = LDSCTL_OFF + 320;
constexpr int LDS_BYTES = RING_BYTES + 1024;

#define GAS __attribute__((address_space(1)))
#define LAS __attribute__((address_space(3)))
typedef unsigned short bf16;
typedef unsigned v4u __attribute__((ext_vector_type(4)));
typedef float f32x4 __attribute__((ext_vector_type(4)));
typedef GAS unsigned gu32;
#define RLX_AGENT __ATOMIC_RELAXED, __HIP_MEMORY_SCOPE_AGENT
#define LDS_WAIT() asm volatile("s_waitcnt lgkmcnt(0)" ::: "memory")
#define VM_WAIT() asm volatile("s_waitcnt vmcnt(0)" ::: "memory")

__device__ __forceinline__ unsigned f2bf(float f) { unsigned u = __builtin_bit_cast(unsigned, f); return (u + 0x7fffu + ((u >> 16) & 1u)) >> 16; }
__device__ __forceinline__ unsigned pk2(float lo, float hi) { return f2bf(lo) | (f2bf(hi) << 16); }
__device__ __forceinline__ float bf2f(unsigned short b) { return __builtin_bit_cast(float, (unsigned)b << 16); }
__device__ __forceinline__ float bflo(unsigned w) { return __builtin_bit_cast(float, w << 16); }
__device__ __forceinline__ float bfhi(unsigned w) { return __builtin_bit_cast(float, w & 0xffff0000u); }
__device__ __forceinline__ float silu_f(float v) { return v / (1.f + __expf(-v)); }
__device__ __forceinline__ float logsigmoid_f(float v) { return fminf(v, 0.f) - log1pf(__expf(-fabsf(v))); }

#define XB_TMO      128
#define XB_XCNT(j)  (256  + 64 * (j))
#define XB_XSUB(j)  (1280 + 64 * (j))
#define XB_XGEN(j)  (2304 + 64 * (j))
#define XB_TOP      3328
#define XB_TOPGEN   3392
#define XCD_BAR_WORDS 3456
#define XB_SPIN_CAP (1u << 22)
__device__ __forceinline__ unsigned xb_ld(unsigned* p)              { return __hip_atomic_load(p, __ATOMIC_RELAXED, __HIP_MEMORY_SCOPE_AGENT); }
__device__ __forceinline__ unsigned xb_add(unsigned* p, unsigned v) { return __hip_atomic_fetch_add(p, v, __ATOMIC_RELAXED, __HIP_MEMORY_SCOPE_AGENT); }
__device__ __forceinline__ unsigned xb_xcc_id() { return (unsigned)__builtin_amdgcn_s_getreg((3 << 11) | 20) & 0xFu; }
#define XB_SPIN(cond, bar) do { unsigned _sp = 0; while (cond) { __builtin_amdgcn_s_sleep(1); \
    if ((++_sp & 255u) == 0u) { if (xb_ld(&(bar)[XB_TMO])) break; if (_sp > XB_SPIN_CAP) { atomicAdd(&(bar)[XB_TMO], 1u); break; } } } } while (0)
struct XcdBarrier { unsigned* bar; unsigned x; volatile LAS unsigned* st; };
__device__ __forceinline__ XcdBarrier xcd_barrier_post(unsigned* bar, volatile LAS unsigned* st) {
    XcdBarrier b; b.bar = bar; b.x = xb_xcc_id(); b.st = st;
    if (threadIdx.x == 0) (void)xb_add(&bar[XB_XCNT(b.x)], 1u);
    return b;
}
__device__ __forceinline__ void xcd_barrier_complete(unsigned* bar, unsigned x, unsigned& nloc, unsigned& nx) {
    const unsigned G = gridDim.x * gridDim.y * gridDim.z;
    unsigned sum, cnt, mine, sp = 0u;
    for (;;) {
        sum = 0u; cnt = 0u; mine = 0u;
#pragma unroll
        for (unsigned j = 0; j < 16; ++j) { const unsigned c = xb_ld(&bar[XB_XCNT(j)]); sum += c; cnt += (c > 0u) ? 1u : 0u; mine = (j == x) ? c : mine; }
        if (sum == G) break;
        __builtin_amdgcn_s_sleep(1);
        if ((++sp & 255u) == 0u) { if (xb_ld(&bar[XB_TMO])) break; if (sp > XB_SPIN_CAP) { atomicAdd(&bar[XB_TMO], 1u); break; } }
    }
    nloc = mine > 0u ? mine : 1u; nx = cnt > 0u ? cnt : 1u;
}
__device__ __forceinline__ void xcd_barrier(const XcdBarrier& b) {
    asm volatile("s_waitcnt vmcnt(0)" ::: "memory");
    __syncthreads();
    if (threadIdx.x == 0) {
        unsigned* bar = b.bar;
        __builtin_amdgcn_s_waitcnt(0);
        unsigned nloc = b.st[0], nx = b.st[1];
        if (nloc == 0u) { xcd_barrier_complete(bar, b.x, nloc, nx); b.st[0] = nloc; b.st[1] = nx; }
        const unsigned old = xb_add(&bar[XB_XSUB(b.x)], 1u);
        const unsigned gen = old / nloc;
        if (old + 1u == (gen + 1u) * nloc) {
            __builtin_amdgcn_fence(__ATOMIC_RELEASE, "agent");
            asm volatile("s_waitcnt vmcnt(0)" ::: "memory");
            const unsigned og = xb_add(&bar[XB_TOP], 1u);
            const unsigned tg = og / nx;
            if (og + 1u == (tg + 1u) * nx) xb_add(&bar[XB_TOPGEN], 1u);
            else XB_SPIN(xb_ld(&bar[XB_TOPGEN]) == tg, bar);
            __builtin_amdgcn_fence(__ATOMIC_ACQUIRE, "agent");
            xb_add(&bar[XB_XGEN(b.x)], 1u);
            asm volatile("s_waitcnt vmcnt(0)" ::: "memory");
        } else {
            XB_SPIN(xb_ld(&bar[XB_XGEN(b.x)]) == gen, bar);
            __builtin_amdgcn_fence(__ATOMIC_ACQUIRE, "agent");
            asm volatile("s_waitcnt vmcnt(0)" ::: "memory");
        }
    }
    __syncthreads();
}

namespace pg8 {
#define PG8_LAS __attribute__((address_space(3)))
typedef unsigned short bf16_t;
typedef short bf16x8 __attribute__((ext_vector_type(8)));
typedef float f32x4 __attribute__((ext_vector_type(4)));
typedef unsigned u32x4 __attribute__((ext_vector_type(4)));
constexpr int BM = 256, BK = 64, HALF = 128, HTB = HALF * BK * 2  , STAGE_BYTES = 8 * HTB, NXCD = 8, WGM = 8;

__host__ __device__ __forceinline__ int lds_byte(int r, int c) { const int st = (r >> 4) * 2 + (c >> 5), rr = r & 15, cc = c & 31, ob = rr * 64 + cc * 2; return st * 1024 + (ob ^ (((ob >> 9) & 1) << 5)); }
__host__ __device__ __forceinline__ void stage_rc(int b, int& R, int& C) { const int st = b / 1024, sb = b % 1024, swz = sb ^ (((sb >> 9) & 1) << 5); R = (st >> 1) * 16 + swz / 64; C = (st & 1) * 32 + (swz % 64) / 2; }
__host__ __device__ __forceinline__ int perm32(int rho) { const int n = rho >> 4, i = rho & 15; return 8 * (i >> 2) + 4 * n + (i & 3); }

struct Unit { int pm, pn; };
struct Gemm { const bf16_t* A; const bf16_t* Bt; int M, N, K; };

struct StaticOrder {
    int nM, nN, nwg, G, c;
    __host__ __device__ void init(int M, int N, int G_, int c_) { nM = M / BM; nN = N / BM; nwg = nM * nN; G = G_; c = c_; }
    __host__ __device__ bool next(int i, Unit& u) const {
        const long L = (long)i * G + c; if (L >= nwg) return false;
        int wgid = (int)L; { const int q = nwg / NXCD, r = nwg % NXCD, xcd = wgid % NXCD, off = wgid / NXCD; wgid = (xcd < r ? xcd * (q + 1) : r * (q + 1) + (xcd - r) * q) + off; }
        const int nig = WGM * nN, gid = wgid / nig, fm = gid * WGM, gsz = (nM - fm) < WGM ? (nM - fm) : WGM;
        u.pm = fm + ((wgid % nig) % gsz); u.pn = (wgid % nig) / gsz; return true;
    }
    __device__ __forceinline__ void a_ready(const Unit&) const {}
    __device__ __forceinline__ void done(const Unit&) const {}
};


__device__ __forceinline__ unsigned cvt_pk_bf16(float lo, float hi) { unsigned r; asm volatile("v_cvt_pk_bf16_f32 %0, %1, %2" : "=v"(r) : "v"(lo), "v"(hi)); return r; }

struct EpiProjFast {
    static constexpr bool PERM = true, AFTER_DRAIN = false;
    bf16_t *QA, *KA, *VA, *SGA, *QB, *KB, *VB, *SGB; float* Gg; const float* b_gate;
    __device__ __forceinline__ void operator()(const f32x4 (&acc)[2][2][4][2], const Unit& u, int wr, int wc, int fr, int fq) const {
        const int pn = u.pn, row0 = u.pm * BM + wr * 64 + fr, col0 = wc * 32 + 8 * fq;
        if (pn == 14) {
            f32x4 bv[2][2];
#pragma unroll
            for (int bj = 0; bj < 2; ++bj)
#pragma unroll
                for (int n = 0; n < 2; ++n) bv[bj][n] = *(const f32x4*)(b_gate + col0 + bj * HALF + 4 * n);
#pragma unroll
            for (int ai = 0; ai < 2; ++ai)
#pragma unroll
                for (int m = 0; m < 4; ++m) { float* rowp = Gg + (size_t)(row0 + ai * HALF + m * 16) * 256 + col0;
#pragma unroll
                    for (int bj = 0; bj < 2; ++bj)
#pragma unroll
                        for (int n = 0; n < 2; ++n) { f32x4 v = acc[ai][bj][m][n] + bv[bj][n];
#pragma unroll
                            for (int e = 0; e < 4; ++e) v[e] = logsigmoid_f(v[e]) * (1.f / 16.f);
                            *(f32x4*)(rowp + bj * HALF + 4 * n) = v; } }
            return;
        }
        bf16_t* base; int ldc = 512, cofs; float sc = 1.f; bool act = false;
        if (pn < 2) { base = QA; cofs = pn * 256; sc = C2; }
        else if (pn < 4) { base = KA; cofs = (pn - 2) * 256; }
        else if (pn < 6) { base = VA; cofs = (pn - 4) * 256; }
        else if (pn < 8) { base = SGA; cofs = (pn - 6) * 256; act = true; }
        else if (pn == 8) { base = QB; ldc = 256; cofs = 0; sc = 0.125f; }
        else if (pn == 9) { base = KB; ldc = 256; cofs = 0; }
        else if (pn < 12) { base = VB; cofs = (pn - 10) * 256; }
        else { base = SGB; cofs = (pn - 12) * 256; act = true; }
#pragma unroll
        for (int ai = 0; ai < 2; ++ai)
#pragma unroll
            for (int m = 0; m < 4; ++m) { bf16_t* rowp = base + (size_t)(row0 + ai * HALF + m * 16) * ldc + cofs + col0;
#pragma unroll
                for (int bj = 0; bj < 2; ++bj) { f32x4 v0 = acc[ai][bj][m][0], v1 = acc[ai][bj][m][1];
                    if (act) {
#pragma unroll
                        for (int e = 0; e < 4; ++e) { v0[e] = v0[e] * __builtin_amdgcn_rcpf(1.f + __expf(-v0[e])); v1[e] = v1[e] * __builtin_amdgcn_rcpf(1.f + __expf(-v1[e])); }
                    } else { v0 = v0 * sc; v1 = v1 * sc; }
                    u32x4 w; w.x = cvt_pk_bf16(v0[0], v0[1]); w.y = cvt_pk_bf16(v0[2], v0[3]); w.z = cvt_pk_bf16(v1[0], v1[1]); w.w = cvt_pk_bf16(v1[2], v1[3]);
                    *(u32x4*)(rowp + bj * HALF) = w; } }
    }
};
struct EpiResFast {
    static constexpr bool PERM = false, AFTER_DRAIN = false;
    const float* x; float* out;
    __device__ __forceinline__ void operator()(const f32x4 (&acc)[2][2][4][2], const Unit& u, int wr, int wc, int fr, int fq) const {
        const int row0 = u.pm * BM + wr * 64 + fr, col0 = u.pn * BM + wc * 32 + 4 * fq;
#pragma unroll
        for (int ai = 0; ai < 2; ++ai)
#pragma unroll
            for (int m = 0; m < 4; ++m) { const size_t off = (size_t)(row0 + ai * HALF + m * 16) * 1024 + col0;
#pragma unroll
                for (int bj = 0; bj < 2; ++bj)
#pragma unroll
                    for (int n = 0; n < 2; ++n) { const size_t i = off + bj * HALF + n * 16; *(f32x4*)(out + i) = *(const f32x4*)(x + i) + acc[ai][bj][m][n]; } }
    }
};
template <class Epi, class Sched, bool ALIGN_EPI = false, bool SP2 = false>
__device__ __forceinline__ void gemm_phase(PG8_LAS unsigned char* lds, const Gemm g, const Sched& S, const Epi& E) {
    const int tid = threadIdx.x, wid = __builtin_amdgcn_readfirstlane(tid >> 6), lane = tid & 63, wr = wid >> 2, wc = wid & 3, fr = lane & 15, fq = lane >> 4;
    const int K = g.K, nt = K / BK;
    unsigned voffA[2], voffB[2];
#pragma unroll
    for (int i = 0; i < 2; ++i) { int R, C; stage_rc(tid * 16 + i * 8192, R, C); const int Rb = Epi::PERM ? ((R & ~31) + perm32(R & 31)) : R;
        voffA[i] = (unsigned)(R * K + C) * 2u; voffB[i] = (unsigned)(Rb * K + C) * 2u; }
    const size_t kstep = (size_t)(BK * 2);
    const size_t hstep = (size_t)HALF * K * 2;
    const size_t tstep = 2 * hstep;
    const unsigned ldsw = (unsigned)wid * 1024u;
    const int aoff = lds_byte(wr * 64 + fr, fq * 8), boff = lds_byte(wc * 32 + fr, fq * 8);
#define PG8_SA(b, h) (((b) * 2 + (h)) * HTB)
#define PG8_SB(b, h) ((4 + (b) * 2 + (h)) * HTB)
#define PG8_STAGE(bufoff, gbase, voff) do { _Pragma("unroll") for (int _i = 0; _i < 2; ++_i) \
        __builtin_amdgcn_global_load_lds((const unsigned*)((const char*)(gbase) + (voff)[_i]), (PG8_LAS unsigned*)(lds + (bufoff) + ldsw + _i * 8192), 16, 0, 0); } while (0)
#define PG8_LDA(dst, b, h) do { _Pragma("unroll") for (int m = 0; m < 4; ++m) _Pragma("unroll") for (int k = 0; k < 2; ++k) dst[m][k] = *(const PG8_LAS bf16x8*)(lds + PG8_SA(b, h) + aoff + m * 2048 + k * 1024); } while (0)
#define PG8_LDB(dst, b, h) do { _Pragma("unroll") for (int n = 0; n < 2; ++n) _Pragma("unroll") for (int k = 0; k < 2; ++k) dst[n][k] = *(const PG8_LAS bf16x8*)(lds + PG8_SB(b, h) + boff + n * 2048 + k * 1024); } while (0)
#define PG8_MMA(ai, bj, At, Bt) do { __builtin_amdgcn_s_setprio(1); _Pragma("unroll") for (int m = 0; m < 4; ++m) _Pragma("unroll") for (int n = 0; n < 2; ++n) _Pragma("unroll") for (int k = 0; k < 2; ++k) \
        acc[ai][bj][m][n] = __builtin_amdgcn_mfma_f32_16x16x32_bf16(Bt[n][k], At[m][k], acc[ai][bj][m][n], 0, 0, 0); __builtin_amdgcn_s_setprio(0); } while (0)
#define PG8_WAIT_V(n) asm volatile("s_waitcnt vmcnt(" #n ")" ::: "memory")
#define PG8_WAIT_L(n) asm volatile("s_waitcnt lgkmcnt(" #n ")" ::: "memory")
#define PG8_BAR __builtin_amdgcn_s_barrier()
#define PG8_SCHED __builtin_amdgcn_sched_barrier(0)
    Unit cur, nxt; int ui = 0;
    if (!S.next(0, cur)) return;
    f32x4 acc[2][2][4][2];
#pragma unroll
    for (int a = 0; a < 2; ++a)
#pragma unroll
        for (int b = 0; b < 2; ++b)
#pragma unroll
            for (int m = 0; m < 4; ++m)
#pragma unroll
                for (int n = 0; n < 2; ++n) acc[a][b][m][n] = (f32x4){0.f, 0.f, 0.f, 0.f};
    bf16x8 At[4][2], B0[2][2], B1[2][2];
    const char* cA = (const char*)g.A + (size_t)cur.pm * tstep; const char* cB = (const char*)g.Bt + (size_t)cur.pn * tstep;
    S.a_ready(cur);
    if constexpr (SP2) {
        PG8_STAGE(PG8_SB(0, 0), cB, voffB); PG8_STAGE(PG8_SB(0, 1), cB + hstep, voffB); PG8_STAGE(PG8_SA(0, 0), cA, voffA); PG8_STAGE(PG8_SA(0, 1), cA + hstep, voffA);
        if (wr == 1) PG8_BAR;
        PG8_WAIT_V(2); PG8_BAR;
        PG8_STAGE(PG8_SB(1, 0), cB + kstep, voffB); PG8_STAGE(PG8_SA(1, 0), cA + kstep, voffA); PG8_STAGE(PG8_SB(1, 1), cB + hstep + kstep, voffB);
        PG8_WAIT_V(6); PG8_BAR;
    } else {
        PG8_STAGE(PG8_SB(0, 0), cB, voffB); PG8_STAGE(PG8_SA(0, 0), cA, voffA); PG8_STAGE(PG8_SB(0, 1), cB + hstep, voffB); PG8_STAGE(PG8_SA(0, 1), cA + hstep, voffA);
        if (wr == 1) PG8_BAR;
        PG8_WAIT_V(4); PG8_BAR;
        PG8_STAGE(PG8_SB(1, 0), cB + kstep, voffB); PG8_STAGE(PG8_SA(1, 0), cA + kstep, voffA); PG8_STAGE(PG8_SB(1, 1), cB + hstep + kstep, voffB);
        PG8_WAIT_V(6); PG8_BAR;
    }
    for (;;) {
        const bool has_next = S.next(ui + 1, nxt);
        const char* nA = has_next ? (const char*)g.A + (size_t)nxt.pm * tstep : cA; const char* nB = has_next ? (const char*)g.Bt + (size_t)nxt.pn * tstep : cB;
        for (int t = 0; t < nt; t += 2) {
            const bool last = (t == nt - 2);
            const char* a1 = cA + (size_t)(t + 1) * kstep;
            const char* a2 = last ? nA : cA + (size_t)(t + 2) * kstep; const char* b2 = last ? nB : cB + (size_t)(t + 2) * kstep;
            const char* a3 = a2 + kstep; const char* b3 = b2 + kstep;
            if (last && has_next) S.a_ready(nxt);
            if constexpr (SP2) {
            PG8_LDB(B0, 0, 0); PG8_LDB(B1, 0, 1); PG8_SCHED; PG8_LDA(At, 0, 0); PG8_STAGE(PG8_SA(1, 1), a1 + hstep, voffA);
            PG8_WAIT_V(8); PG8_WAIT_L(0); PG8_BAR; PG8_MMA(0, 0, At, B0); PG8_MMA(0, 1, At, B1); PG8_BAR; PG8_SCHED;
            PG8_LDA(At, 0, 1); PG8_STAGE(PG8_SB(0, 0), b2, voffB); PG8_STAGE(PG8_SB(0, 1), b2 + hstep, voffB); PG8_STAGE(PG8_SA(0, 0), a2, voffA);
            PG8_WAIT_V(8); PG8_WAIT_L(0); PG8_BAR; PG8_MMA(1, 0, At, B0); PG8_MMA(1, 1, At, B1); PG8_BAR; PG8_SCHED;
            PG8_LDB(B0, 1, 0); PG8_LDB(B1, 1, 1); PG8_SCHED; PG8_LDA(At, 1, 0); PG8_STAGE(PG8_SA(0, 1), a2 + hstep, voffA);
            PG8_WAIT_V(8); PG8_WAIT_L(0); PG8_BAR; PG8_MMA(0, 0, At, B0); PG8_MMA(0, 1, At, B1); PG8_BAR; PG8_SCHED;
            PG8_LDA(At, 1, 1); PG8_STAGE(PG8_SB(1, 0), b3, voffB); PG8_STAGE(PG8_SB(1, 1), b3 + hstep, voffB); PG8_STAGE(PG8_SA(1, 0), a3, voffA);
            PG8_WAIT_V(8); PG8_WAIT_L(0); PG8_BAR; PG8_MMA(1, 0, At, B0); PG8_MMA(1, 1, At, B1); PG8_BAR; PG8_SCHED;
            } else {
            PG8_LDB(B0, 0, 0); PG8_SCHED; PG8_LDA(At, 0, 0); PG8_STAGE(PG8_SA(1, 1), a1 + hstep, voffA);
            PG8_WAIT_L(8); PG8_BAR; PG8_WAIT_L(0); PG8_MMA(0, 0, At, B0); PG8_BAR; PG8_SCHED;
            PG8_LDB(B1, 0, 1); PG8_STAGE(PG8_SB(0, 0), b2, voffB);
            PG8_BAR; PG8_WAIT_L(0); PG8_MMA(0, 1, At, B1); PG8_BAR;
            PG8_LDA(At, 0, 1); PG8_STAGE(PG8_SA(0, 0), a2, voffA);
            PG8_BAR; PG8_WAIT_L(0); PG8_MMA(1, 0, At, B0); PG8_BAR; PG8_SCHED;
            PG8_STAGE(PG8_SB(0, 1), b2 + hstep, voffB);
            PG8_WAIT_V(6); PG8_BAR; PG8_MMA(1, 1, At, B1); PG8_BAR;
            PG8_LDB(B0, 1, 0); PG8_SCHED; PG8_LDA(At, 1, 0); PG8_STAGE(PG8_SA(0, 1), a2 + hstep, voffA);
            PG8_WAIT_L(8); PG8_BAR; PG8_WAIT_L(0); PG8_MMA(0, 0, At, B0); PG8_BAR; PG8_SCHED;
            PG8_LDB(B1, 1, 1); PG8_STAGE(PG8_SB(1, 0), b3, voffB);
            PG8_BAR; PG8_WAIT_L(0); PG8_MMA(0, 1, At, B1); PG8_BAR;
            PG8_LDA(At, 1, 1); PG8_STAGE(PG8_SA(1, 0), a3, voffA);
            PG8_BAR; PG8_WAIT_L(0); PG8_MMA(1, 0, At, B0); PG8_BAR; PG8_SCHED;
            PG8_STAGE(PG8_SB(1, 1), b3 + hstep, voffB);
            PG8_WAIT_V(6); PG8_BAR; PG8_MMA(1, 1, At, B1); PG8_BAR;
            }
        }
        if constexpr (ALIGN_EPI) { if (wr == 0) PG8_BAR; }
        if constexpr (!Epi::AFTER_DRAIN) { E(acc, cur, wr, wc, fr, fq); S.done(cur); }
        if (!has_next) break;
#pragma unroll
        for (int a = 0; a < 2; ++a)
#pragma unroll
            for (int b = 0; b < 2; ++b)
#pragma unroll
                for (int m = 0; m < 4; ++m)
#pragma unroll
                    for (int n = 0; n < 2; ++n) acc[a][b][m][n] = (f32x4){0.f, 0.f, 0.f, 0.f};
        cur = nxt; cA = nA; cB = nB; ++ui;
        if constexpr (ALIGN_EPI) { if (wr == 1) PG8_BAR; }
    }
    PG8_WAIT_V(0);
    if constexpr (!ALIGN_EPI) { if (wr == 0) PG8_BAR; }
    PG8_BAR;
    if constexpr (Epi::AFTER_DRAIN) { E.fused(acc, cur, wr, wc, fr, fq, lds, wid, lane); S.done(cur); }
#undef PG8_SA
#undef PG8_SB
#undef PG8_STAGE
#undef PG8_LDA
#undef PG8_LDB
#undef PG8_MMA
#undef PG8_WAIT_V
#undef PG8_WAIT_L
#undef PG8_BAR
#undef PG8_SCHED
}
}

struct Frame {
    LAS unsigned char* lds;
    volatile LAS unsigned* MISC;
    gu32* ctl;
    int tid, lane, wave, vcu, G;
    const float *x, *norm_w, *w_in, *w_gate_up, *b_gate, *lq1, *lk1, *lq2, *lk2, *subln_w, *gla_w, *w_out, *fin_w;
    float* out;
    bf16 *Win_t, *Wout_t, *XN, *Y, *QA, *KA, *VA, *SGA, *QB, *KB, *VB, *SGB;
    float *Gg, *O1, *GST;
};
__device__ __forceinline__ float wave_sum(float v) {
#pragma unroll
    for (int o = 1; o < 64; o <<= 1) v += __shfl_xor(v, o);
    return v;
}

__device__ __forceinline__ void p0_transpose_item(const float* W, int K, int ldw, int nblk, const float* ks, bf16* WT, int row_off, LAS float* scr, int item, int lane) {
    const int kb = item / nblk, nb = item % nblk, k0 = 64 * kb, n0 = 32 * nb;
#pragma unroll 8
    for (int i = 0; i < 32; ++i) { const int kk = 2 * i + (lane >> 5); float v = W[(size_t)(k0 + kk) * ldw + n0 + (lane & 31)]; if (ks) v *= ks[k0 + kk]; scr[kk * 33 + (lane & 31)] = v; }
    LDS_WAIT(); asm volatile("" ::: "memory");
    const int c = lane & 7;
#pragma unroll
    for (int j = 0; j < 4; ++j) { const int n = (lane >> 3) + 8 * j; const LAS float* s = scr + (8 * c) * 33 + n;
        v4u o; o.x = pk2(s[0 * 33], s[1 * 33]); o.y = pk2(s[2 * 33], s[3 * 33]); o.z = pk2(s[4 * 33], s[5 * 33]); o.w = pk2(s[6 * 33], s[7 * 33]);
        *(GAS v4u*)(WT + (size_t)(row_off + n0 + n) * K + k0 + 8 * c) = o; }
    LDS_WAIT(); asm volatile("" ::: "memory");
}
__device__ __forceinline__ void rms_row_to_bf16(Frame& F, const float* xrow, bf16* orow) {
    const GAS f32x4* xr = (const GAS f32x4*)xrow + F.lane;
    f32x4 v[4]; float s = 0.f;
#pragma unroll
    for (int j = 0; j < 4; ++j) { v[j] = xr[64 * j]; s += (v[j].x * v[j].x + v[j].y * v[j].y) + (v[j].z * v[j].z + v[j].w * v[j].w); }
    const float rstd = 1.f / sqrtf(wave_sum(s) * (1.f / D) + EPS);
    GAS unsigned long long* o8 = (GAS unsigned long long*)orow + F.lane;
#pragma unroll
    for (int j = 0; j < 4; ++j) o8[64 * j] = (unsigned long long)pk2(v[j].x * rstd, v[j].y * rstd) | ((unsigned long long)pk2(v[j].z * rstd, v[j].w * rstd) << 32);
}
__device__ __forceinline__ void p0_prologue(Frame& F) {
    LAS float* scr = (LAS float*)(F.lds + F.wave * 16384);
    const int gw = F.vcu * NWAVES + F.wave, NGW = F.G * NWAVES;
    constexpr int I_IN = (D / 64) * (3584 / 32), I_OUT = (D / 64) * (D / 32);
    for (int it = gw; it < I_IN + I_OUT; it += NGW) {
        if (it < I_IN) p0_transpose_item(F.w_in, D, IN_COLS, 3584 / 32, F.norm_w, F.Win_t, 0, scr, it, F.lane);
        else p0_transpose_item(F.w_out, D, D, D / 32, nullptr, F.Wout_t, 0, scr, it - I_IN, F.lane);
    }
    const int gt = (F.vcu * NWAVES + F.wave) * 64 + F.lane, NGT = NGW * 64;
    for (int it = gt; it < 256 * (D / 8); it += NGT) {
        const int j = it / (D / 8), k0 = (it % (D / 8)) * 8;
        float wg[16];
#pragma unroll
        for (int r = 0; r < 16; ++r) wg[r] = F.w_gate_up[r * 256 + j];
        float o[8];
#pragma unroll
        for (int i = 0; i < 8; ++i) { const float* wr = F.w_in + (size_t)(k0 + i) * IN_COLS + 3584; float a = 0.f;
#pragma unroll
            for (int r = 0; r < 16; ++r) a += wr[r] * wg[r];
            o[i] = a * F.norm_w[k0 + i]; }
        v4u w; w.x = pk2(o[0], o[1]); w.y = pk2(o[2], o[3]); w.z = pk2(o[4], o[5]); w.w = pk2(o[6], o[7]);
        *(GAS v4u*)(F.Win_t + (size_t)(3584 + j) * D + k0) = w;
    }
    for (int m = gw; m < M; m += NGW) rms_row_to_bf16(F, F.x + (size_t)m * D, F.XN + (size_t)m * D);
}

__device__ __forceinline__ float lambda_full(Frame& F) {
    float s1 = 0.f, s2 = 0.f;
    for (int i = 0; i < 64; ++i) { s1 += F.lq1[i] * F.lk1[i]; s2 += F.lq2[i] * F.lk2[i]; }
    return __expf(s1) - __expf(s2) + LAM_INIT;
}
__device__ __forceinline__ void simple_attn(Frame& F) {
    LAS float* Ks = (LAS float*)F.lds;
    LAS float* Vs = Ks + 64 * 64;
    const int tid = F.tid;
    const float lam = lambda_full(F);
    for (int u = blockIdx.x; u < 256; u += gridDim.x) {
        const int b = u >> 5, h = (u >> 3) & 3, p = u & 7;
        const float slope2 = exp2f(-2.f * (float)(h + 1)) * LOG2E;
        for (int half = 0; half < 2; ++half) {
            const int rb = half ? 15 - p : p;
            const int row = rb * 512 + tid;
            const size_t grow = (size_t)b * T + row;
            const int ntiles = (rb * 512 + 512) / 64;
            float ssq = 0.f;
            float* o1 = F.O1 + grow * 512 + h * 128;
            for (int pass = 0; pass < 4; ++pass) {
                const int sub = pass >> 1, eh = pass & 1;
                unsigned qw[32];
                { const GAS v4u* qp = (const GAS v4u*)(F.QA + grow * 512 + h * 128 + sub * 64);
#pragma unroll
                  for (int i = 0; i < 8; ++i) { const v4u w = qp[i]; qw[4 * i] = w.x; qw[4 * i + 1] = w.y; qw[4 * i + 2] = w.z; qw[4 * i + 3] = w.w; } }
                float mx = -1e30f, l = 0.f; float o[64];
#pragma unroll
                for (int e = 0; e < 64; ++e) o[e] = 0.f;
                for (int kt = 0; kt < ntiles; ++kt) {
                    __syncthreads();
                    { const int key = tid >> 3, seg = (tid & 7) * 8; const size_t kr = (size_t)b * T + kt * 64 + key;
                      const v4u w = *(const GAS v4u*)(F.KA + kr * 512 + h * 128 + sub * 64 + seg);
                      LAS float* d = Ks + key * 64 + seg; d[0] = bflo(w.x); d[1] = bfhi(w.x); d[2] = bflo(w.y); d[3] = bfhi(w.y); d[4] = bflo(w.z); d[5] = bfhi(w.z); d[6] = bflo(w.w); d[7] = bfhi(w.w);
                      const v4u x = *(const GAS v4u*)(F.VA + kr * 512 + h * 128 + eh * 64 + seg);
                      LAS float* e = Vs + key * 64 + seg; e[0] = bflo(x.x); e[1] = bfhi(x.x); e[2] = bflo(x.y); e[3] = bfhi(x.y); e[4] = bflo(x.z); e[5] = bfhi(x.z); e[6] = bflo(x.w); e[7] = bfhi(x.w); }
                    __syncthreads();
                    const int jn = row - kt * 64;
                    for (int j = 0; j < 64; ++j) {
                        if (j > jn) break;
                        float s = 0.f;
#pragma unroll
                        for (int dd = 0; dd < 32; ++dd) { s += bflo(qw[dd]) * Ks[j * 64 + 2 * dd]; s += bfhi(qw[dd]) * Ks[j * 64 + 2 * dd + 1]; }
                        s -= slope2 * (float)(jn - j);
                        if (s > mx) { const float al = exp2f(mx - s); l *= al;
#pragma unroll
                            for (int e = 0; e < 64; ++e) o[e] *= al;
                            mx = s; }
                        const float pp = exp2f(s - mx); l += pp;
#pragma unroll
                        for (int e = 0; e < 64; ++e) o[e] += pp * Vs[j * 64 + e];
                    }
                }
                const float rl = 1.f / l;
                if (sub == 0) {
#pragma unroll
                    for (int e = 0; e < 64; e += 4) *(GAS f32x4*)(o1 + eh * 64 + e) = (f32x4){o[e] * rl, o[e + 1] * rl, o[e + 2] * rl, o[e + 3] * rl};
                } else {
#pragma unroll
                    for (int e = 0; e < 64; e += 4) { const f32x4 a = *(const GAS f32x4*)(o1 + eh * 64 + e);
                        const f32x4 dv = (f32x4){a.x - lam * o[e] * rl, a.y - lam * o[e + 1] * rl, a.z - lam * o[e + 2] * rl, a.w - lam * o[e + 3] * rl};
                        ssq += (dv.x * dv.x + dv.y * dv.y) + (dv.z * dv.z + dv.w * dv.w);
                        *(GAS f32x4*)(o1 + eh * 64 + e) = dv; }
                }
            }
            {
                const float rstd = (1.f - LAM_INIT) / sqrtf(ssq * (1.f / 128.f) + EPS);
                const bf16* sg = F.SGA + grow * 512 + h * 128; bf16* y = F.Y + grow * 1024 + h * 128;
                for (int e = 0; e < 128; e += 8) { const v4u g = *(const GAS v4u*)(sg + e); const f32x4 a0 = *(const GAS f32x4*)(o1 + e), a1 = *(const GAS f32x4*)(o1 + e + 4); v4u w;
                    w.x = pk2(a0.x * rstd * F.subln_w[e] * bflo(g.x), a0.y * rstd * F.subln_w[e + 1] * bfhi(g.x));
                    w.y = pk2(a0.z * rstd * F.subln_w[e + 2] * bflo(g.y), a0.w * rstd * F.subln_w[e + 3] * bfhi(g.y));
                    w.z = pk2(a1.x * rstd * F.subln_w[e + 4] * bflo(g.z), a1.y * rstd * F.subln_w[e + 5] * bfhi(g.z));
                    w.w = pk2(a1.z * rstd * F.subln_w[e + 6] * bflo(g.w), a1.w * rstd * F.subln_w[e + 7] * bfhi(g.w));
                    *(GAS v4u*)(y + e) = w; }
            }
        }
    }
    __syncthreads();
}

__device__ __forceinline__ void simple_gla(Frame& F) {
    LAS float* S = (LAS float*)F.lds;
    LAS float* Qi = S + 8192;
    LAS float* Ki = Qi + 4096;
    LAS float* Kst = Ki + 4096;
    LAS float* Vv = Kst + 4096;
    LAS float* Aa = Vv + 8192;
    LAS float* wtot = Aa + 4096;
    LAS float* dec = wtot + 512;
    const int tid = F.tid, d = tid & 63, w = tid >> 6;
    for (int u = blockIdx.x; u < BATCH * H; u += gridDim.x) {
        const int b = u / H, h = u % H;
        __syncthreads();
        for (int i = tid; i < 8192; i += 512) S[i] = 0.f;
        for (int n = 0; n < T / 64; ++n) {
            const size_t tok0 = (size_t)b * T + n * 64;
            float gl[8]; float run = 0.f;
#pragma unroll
            for (int i = 0; i < 8; ++i) { run += F.Gg[(tok0 + 8 * w + i) * 256 + h * 64 + d]; gl[i] = run; }
            __syncthreads();
            wtot[w * 64 + d] = run;
            __syncthreads();
            float off = 0.f, tot = 0.f;
#pragma unroll
            for (int ww = 0; ww < 8; ++ww) { const float v = wtot[ww * 64 + d]; tot += v; if (ww < w) off += v; }
#pragma unroll
            for (int i = 0; i < 8; ++i) { const int t = 8 * w + i; const float bb = gl[i] + off;
                const float qv = bf2f(F.QB[(tok0 + t) * 256 + h * 64 + d]), kv = bf2f(F.KB[(tok0 + t) * 256 + h * 64 + d]);
                Qi[t * 64 + d] = qv * __expf(bb); Ki[t * 64 + d] = kv * __expf(-bb); Kst[t * 64 + d] = kv * __expf(tot - bb); }
            if (w == 0) dec[d] = __expf(tot);
            { const int t = tid >> 3, seg = (tid & 7) * 16;
#pragma unroll
              for (int q2 = 0; q2 < 2; ++q2) { const v4u x = *(const GAS v4u*)(F.VB + (tok0 + t) * 512 + h * 128 + seg + q2 * 8);
                LAS float* e = Vv + t * 128 + seg + q2 * 8; e[0] = bflo(x.x); e[1] = bfhi(x.x); e[2] = bflo(x.y); e[3] = bfhi(x.y); e[4] = bflo(x.z); e[5] = bfhi(x.z); e[6] = bflo(x.w); e[7] = bfhi(x.w); } }
            __syncthreads();
            { const int c = tid >> 3, s0 = (tid & 7) * 8;
#pragma unroll
              for (int si = 0; si < 8; ++si) { const int s = s0 + si; float a = 0.f;
                  for (int dd = 0; dd < 64; ++dd) a += Qi[c * 64 + dd] * Ki[s * 64 + dd];
                  Aa[c * 64 + s] = (s <= c) ? a : 0.f; } }
            __syncthreads();
            { const int c = tid >> 3, e0 = (tid & 7) * 16; float o[16];
#pragma unroll
              for (int i = 0; i < 16; ++i) o[i] = 0.f;
              for (int s = 0; s < 64; ++s) { const float a = Aa[c * 64 + s], qv = Qi[c * 64 + s];
#pragma unroll
                  for (int i = 0; i < 16; ++i) o[i] += a * Vv[s * 128 + e0 + i] + qv * S[s * 128 + e0 + i]; }
              float ssq = 0.f;
#pragma unroll
              for (int i = 0; i < 16; ++i) ssq += o[i] * o[i];
              ssq += __shfl_xor(ssq, 1); ssq += __shfl_xor(ssq, 2); ssq += __shfl_xor(ssq, 4);
              const float rstd = 1.f / sqrtf(ssq * (1.f / 128.f) + EPS);
              const bf16* sg = F.SGB + (tok0 + c) * 512 + h * 128 + e0; bf16* y = F.Y + (tok0 + c) * 1024 + 512 + h * 128 + e0;
#pragma unroll
              for (int q2 = 0; q2 < 2; ++q2) { const v4u g = *(const GAS v4u*)(sg + q2 * 8); const float* gw = F.gla_w + e0 + q2 * 8; const float* oo = o + q2 * 8; v4u wv;
                  wv.x = pk2(oo[0] * rstd * gw[0] * bflo(g.x), oo[1] * rstd * gw[1] * bfhi(g.x));
                  wv.y = pk2(oo[2] * rstd * gw[2] * bflo(g.y), oo[3] * rstd * gw[3] * bfhi(g.y));
                  wv.z = pk2(oo[4] * rstd * gw[4] * bflo(g.z), oo[5] * rstd * gw[5] * bfhi(g.z));
                  wv.w = pk2(oo[6] * rstd * gw[6] * bflo(g.w), oo[7] * rstd * gw[7] * bfhi(g.w));
                  *(GAS v4u*)(y + q2 * 8) = wv; } }
            __syncthreads();
            { const int dd = tid >> 3, e0 = (tid & 7) * 16; float a[16]; const float dc = dec[dd];
#pragma unroll
              for (int i = 0; i < 16; ++i) a[i] = dc * S[dd * 128 + e0 + i];
              for (int t = 0; t < 64; ++t) { const float kv = Kst[t * 64 + dd];
#pragma unroll
                  for (int i = 0; i < 16; ++i) a[i] += kv * Vv[t * 128 + e0 + i]; }
#pragma unroll
              for (int i = 0; i < 16; ++i) S[dd * 128 + e0 + i] = a[i]; }
        }
    }
    __syncthreads();
}

__device__ __forceinline__ void final_norm(Frame& F) {
    const int gw = F.vcu * NWAVES + F.wave, NGW = F.G * NWAVES;
    f32x4 wv[4];
#pragma unroll
    for (int j = 0; j < 4; ++j) wv[j] = ((const GAS f32x4*)F.fin_w)[F.lane + 64 * j];
    for (int m = gw; m < M; m += NGW) {
        GAS f32x4* zr = (GAS f32x4*)(F.out + (size_t)m * D) + F.lane;
        f32x4 v[4]; float s = 0.f;
#pragma unroll
        for (int j = 0; j < 4; ++j) { v[j] = zr[64 * j]; s += (v[j].x * v[j].x + v[j].y * v[j].y) + (v[j].z * v[j].z + v[j].w * v[j].w); }
        const float rstd = 1.f / sqrtf(wave_sum(s) * (1.f / D) + EPS);
#pragma unroll
        for (int j = 0; j < 4; ++j) zr[64 * j] = v[j] * rstd * wv[j];
    }
}

struct Args { const float* in[13]; float* out; unsigned char* ws; int ph_lo, ph_hi, li, pad; };
__global__ void __launch_bounds__(NWAVES * 64, 2) hybrid_fwd(Args args) {
    extern __shared__ __attribute__((aligned(16))) unsigned char lds[];
    Frame F;
    F.lds = (LAS unsigned char*)lds;
    F.MISC = (volatile LAS unsigned*)(F.lds + MISC_OFF);
    F.tid = threadIdx.x; F.lane = F.tid & 63; F.wave = __builtin_amdgcn_readfirstlane(F.tid >> 6);
    F.G = gridDim.x; { const int bx = blockIdx.x; F.vcu = (F.G % 8 == 0) ? (bx % 8) * (F.G / 8) + bx / 8 : bx; }
    unsigned char* ws = args.ws;
    F.ctl = (gu32*)(ws + WS_CTL);
    F.x = args.in[0]; F.norm_w = args.in[1]; F.w_in = args.in[2]; F.w_gate_up = args.in[3]; F.b_gate = args.in[4];
    F.lq1 = args.in[5]; F.lk1 = args.in[6]; F.lq2 = args.in[7]; F.lk2 = args.in[8]; F.subln_w = args.in[9]; F.gla_w = args.in[10];
    F.w_out = args.in[11]; F.fin_w = args.in[12]; F.out = args.out;
    F.Win_t = (bf16*)(ws + WS_WIN); F.Wout_t = (bf16*)(ws + WS_WOUT); F.XN = (bf16*)(ws + WS_XN); F.Y = (bf16*)(ws + WS_Y);
    F.QA = (bf16*)(ws + WS_QA); F.KA = (bf16*)(ws + WS_KA); F.VA = (bf16*)(ws + WS_VA); F.SGA = (bf16*)(ws + WS_SGA);
    F.QB = (bf16*)(ws + WS_QB); F.KB = (bf16*)(ws + WS_KB); F.VB = (bf16*)(ws + WS_VB); F.SGB = (bf16*)(ws + WS_SGB);
    F.Gg = (float*)(ws + WS_G); F.O1 = (float*)(ws + WS_O1); F.GST = (float*)(ws + WS_GST);
    for (int u = F.tid; u < (LDS_BYTES - LDSCTL_OFF) / 4; u += NWAVES * 64) ((LAS unsigned*)(F.lds + LDSCTL_OFF))[u] = 0u;
    __syncthreads();
    XcdBarrier bar; bar.bar = (unsigned*)(F.ctl + CW_BAR); bar.x = 0; bar.st = nullptr;
    if (N_LAUNCHES != PER_PHASE) bar = xcd_barrier_post((unsigned*)(F.ctl + CW_BAR), F.MISC + 8);
#define GRID_BAR(seam) do { if (N_LAUNCHES == PER_PHASE) { if (F.tid == 0) __hip_atomic_store(F.ctl + CW_TMO, 0xBADBA0u | (unsigned)(seam), RLX_AGENT); } else { xcd_barrier(bar); } } while (0)
    const int lo = args.ph_lo, hi = args.ph_hi;
#define IN(k) (lo <= (k) && (k) < hi)
#define BOTH(k) (IN(k) && IN((k) + 1))
    if (IN(0)) { p0_prologue(F); if (BOTH(0)) GRID_BAR(0); }
    if (IN(1)) {
        pg8::Gemm g{F.XN, F.Win_t, M, NP, D}; pg8::StaticOrder S; S.init(M, NP, F.G, (int)blockIdx.x);
        pg8::EpiProjFast E{F.QA, F.KA, F.VA, F.SGA, F.QB, F.KB, F.VB, F.SGB, F.Gg, F.b_gate};
        pg8::gemm_phase<pg8::EpiProjFast, pg8::StaticOrder, true, true>(F.lds, g, S, E);
        if (BOTH(1)) GRID_BAR(1);
    }
    if (IN(2)) { if (BOTH(2)) GRID_BAR(2); }
    if (IN(3)) { simple_attn(F); simple_gla(F); if (BOTH(3)) GRID_BAR(3); }
    if (IN(4)) {
        pg8::Gemm g{F.Y, F.Wout_t, M, D, D}; pg8::StaticOrder S; S.init(M, D, F.G, (int)blockIdx.x);
        pg8::EpiResFast E{F.x, F.out};
        pg8::gemm_phase<pg8::EpiResFast, pg8::StaticOrder, true, true>(F.lds, g, S, E);
        if (BOTH(4)) GRID_BAR(4);
    }
    if (IN(5)) { final_norm(F); }
#undef IN
#undef BOTH
}

extern "C" void kernel_launch(void* const* d_in, const int* in_sizes, int n_in, void* d_out, int out_size, void* d_ws, size_t ws_size, hipStream_t stream) {
    static int grid = 0;
    if (grid == 0) {
        if (n_in != 13 || in_sizes[0] != M * D || out_size != M * D || ws_size < WS_END) { fprintf(stderr, "kernel_launch: shape/workspace mismatch (n_in %d, in0 %d, out %d, ws %zu)\n", n_in, n_in > 0 ? in_sizes[0] : -1, out_size, ws_size); grid = -1; return; }
        int dev = 0, cus = 0, per_cu = 0;
        if (hipGetDevice(&dev) != hipSuccess || hipDeviceGetAttribute(&cus, hipDeviceAttributeMultiprocessorCount, dev) != hipSuccess) { grid = -1; return; }
        if (hipFuncSetAttribute((const void*)hybrid_fwd, hipFuncAttributeMaxDynamicSharedMemorySize, LDS_BYTES) != hipSuccess) { fprintf(stderr, "kernel_launch: hipFuncSetAttribute failed\n"); grid = -1; return; }
        if (hipOccupancyMaxActiveBlocksPerMultiprocessor(&per_cu, (const void*)hybrid_fwd, NWAVES * 64, LDS_BYTES) != hipSuccess || per_cu < 1) { fprintf(stderr, "kernel_launch: occupancy query says %d\n", per_cu); per_cu = 1; }
        (void)hipGetLastError();
        grid = cus;
    }
    if (grid < 0) return;
    (void)hipMemsetAsync((char*)d_ws + WS_CTL, 0, CTL_ZERO_BYTES, stream);
    Args a{};
    for (int i = 0; i < 13; ++i) a.in[i] = (const float*)d_in[i];
    a.out = (float*)d_out; a.ws = (unsigned char*)d_ws;
    if (N_LAUNCHES == 1) { a.ph_lo = 0; a.ph_hi = PER_PHASE; a.li = 0; hipLaunchKernelGGL(hybrid_fwd, dim3(grid), dim3(NWAVES * 64), LDS_BYTES, stream, a); }
    else for (int li = 0; li < PER_PHASE; ++li) { a.ph_lo = li; a.ph_hi = li + 1; a.li = li; hipLaunchKernelGGL(hybrid_fwd, dim3(grid), dim3(NWAVES * 64), LDS_BYTES, stream, a); }
}
```

```cpp
#include <hip/hip_runtime.h>
#include <cstdio>
#include <cstdint>

#ifndef MK_N_LAUNCHES
#define MK_N_LAUNCHES 1
#endif
constexpr int N_LAUNCHES = MK_N_LAUNCHES;
constexpr int PER_PHASE = 6;
constexpr int NWAVES = 8;

constexpr int BATCH = 8, T = 8192, D = 1024, M = BATCH * T;
constexpr int H = 4;
constexpr int IN_COLS = 3600;
constexpr int NP = 3840;
constexpr float EPS = 1e-6f;
constexpr float LOG2E = 1.4426950408889634f;
constexpr float C2 = 0.125f * LOG2E;
constexpr float LAM_INIT = 0.2f;

constexpr size_t MiB = 1u << 20;
constexpr size_t WS_CTL = 0, CTL_ZERO_BYTES = 1 * MiB;
constexpr size_t WS_WIN = 2 * MiB;
constexpr size_t WS_WOUT = 10 * MiB;
constexpr size_t WS_GST = 16 * MiB;
constexpr size_t WS_XN = 32 * MiB;
constexpr size_t WS_Y = 160 * MiB;
constexpr size_t WS_QA = 288 * MiB, WS_KA = 352 * MiB, WS_VA = 416 * MiB, WS_SGA = 480 * MiB;
constexpr size_t WS_QB = 544 * MiB, WS_KB = 576 * MiB;
constexpr size_t WS_VB = 608 * MiB, WS_SGB = 672 * MiB;
constexpr size_t WS_G = 736 * MiB;
constexpr size_t WS_O1 = 800 * MiB;
constexpr size_t WS_END = 928 * MiB;
constexpr int CW_TMO = 0, CW_CODE = 1, CW_BAR = 4096;

constexpr int RING_BYTES = 147456;
constexpr int LDSCTL_OFF = RING_BYTES, MISC_OFF = LDSCTL_OFF + 320;
constexpr int LDS_BYTES = RING_BYTES + 1024;

#define GAS __attribute__((address_space(1)))
#define LAS __attribute__((address_space(3)))
typedef unsigned short bf16;
typedef unsigned v4u __attribute__((ext_vector_type(4)));
typedef float f32x4 __attribute__((ext_vector_type(4)));
typedef GAS unsigned gu32;
#define RLX_AGENT __ATOMIC_RELAXED, __HIP_MEMORY_SCOPE_AGENT
#define LDS_WAIT() asm volatile("s_waitcnt lgkmcnt(0)" ::: "memory")
#define VM_WAIT() asm volatile("s_waitcnt vmcnt(0)" ::: "memory")

__device__ __forceinline__ unsigned f2bf(float f) { unsigned u = __builtin_bit_cast(unsigned, f); return (u + 0x7fffu + ((u >> 16) & 1u)) >> 16; }
__device__ __forceinline__ unsigned pk2(float lo, float hi) { return f2bf(lo) | (f2bf(hi) << 16); }
__device__ __forceinline__ float bf2f(unsigned short b) { return __builtin_bit_cast(float, (unsigned)b << 16); }
__device__ __forceinline__ float bflo(unsigned w) { return __builtin_bit_cast(float, w << 16); }
__device__ __forceinline__ float bfhi(unsigned w) { return __builtin_bit_cast(float, w & 0xffff0000u); }
__device__ __forceinline__ float silu_f(float v) { return v / (1.f + __expf(-v)); }
__device__ __forceinline__ float logsigmoid_f(float v) { return fminf(v, 0.f) - log1pf(__expf(-fabsf(v))); }

#define XB_TMO      128
#define XB_XCNT(j)  (256  + 64 * (j))
#define XB_XSUB(j)  (1280 + 64 * (j))
#define XB_XGEN(j)  (2304 + 64 * (j))
#define XB_TOP      3328
#define XB_TOPGEN   3392
#define XCD_BAR_WORDS 3456
#define XB_SPIN_CAP (1u << 22)
__device__ __forceinline__ unsigned xb_ld(unsigned* p)              { return __hip_atomic_load(p, __ATOMIC_RELAXED, __HIP_MEMORY_SCOPE_AGENT); }
__device__ __forceinline__ unsigned xb_add(unsigned* p, unsigned v) { return __hip_atomic_fetch_add(p, v, __ATOMIC_RELAXED, __HIP_MEMORY_SCOPE_AGENT); }
__device__ __forceinline__ unsigned xb_xcc_id() { return (unsigned)__builtin_amdgcn_s_getreg((3 << 11) | 20) & 0xFu; }
#define XB_SPIN(cond, bar) do { unsigned _sp = 0; while (cond) { __builtin_amdgcn_s_sleep(1); \
    if ((++_sp & 255u) == 0u) { if (xb_ld(&(bar)[XB_TMO])) break; if (_sp > XB_SPIN_CAP) { atomicAdd(&(bar)[XB_TMO], 1u); break; } } } } while (0)
struct XcdBarrier { unsigned* bar; unsigned x; volatile LAS unsigned* st; };
__device__ __forceinline__ XcdBarrier xcd_barrier_post(unsigned* bar, volatile LAS unsigned* st) {
    XcdBarrier b; b.bar = bar; b.x = xb_xcc_id(); b.st = st;
    if (threadIdx.x == 0) (void)xb_add(&bar[XB_XCNT(b.x)], 1u);
    return b;
}
__device__ __forceinline__ void xcd_barrier_complete(unsigned* bar, unsigned x, unsigned& nloc, unsigned& nx) {
    const unsigned G = gridDim.x * gridDim.y * gridDim.z;
    unsigned sum, cnt, mine, sp = 0u;
    for (;;) {
        sum = 0u; cnt = 0u; mine = 0u;
#pragma unroll
        for (unsigned j = 0; j < 16; ++j) { const unsigned c = xb_ld(&bar[XB_XCNT(j)]); sum += c; cnt += (c > 0u) ? 1u : 0u; mine = (j == x) ? c : mine; }
        if (sum == G) break;
        __builtin_amdgcn_s_sleep(1);
        if ((++sp & 255u) == 0u) { if (xb_ld(&bar[XB_TMO])) break; if (sp > XB_SPIN_CAP) { atomicAdd(&bar[XB_TMO], 1u); break; } }
    }
    nloc = mine > 0u ? mine : 1u; nx = cnt > 0u ? cnt : 1u;
}
__device__ __forceinline__ void xcd_barrier(const XcdBarrier& b) {
    asm volatile("s_waitcnt vmcnt(0)" ::: "memory");
    __syncthreads();
    if (threadIdx.x == 0) {
        unsigned* bar = b.bar;
        __builtin_amdgcn_s_waitcnt(0);
        unsigned nloc = b.st[0], nx = b.st[1];
        if (nloc == 0u) { xcd_barrier_complete(bar, b.x, nloc, nx); b.st[0] = nloc; b.st[1] = nx; }
        const unsigned old = xb_add(&bar[XB_XSUB(b.x)], 1u);
        const unsigned gen = old / nloc;
        if (old + 1u == (gen + 1u) * nloc) {
            __builtin_amdgcn_fence(__ATOMIC_RELEASE, "agent");
            asm volatile("s_waitcnt vmcnt(0)" ::: "memory");
            const unsigned og = xb_add(&bar[XB_TOP], 1u);
            const unsigned tg = og / nx;
            if (og + 1u == (tg + 1u) * nx) xb_add(&bar[XB_TOPGEN], 1u);
            else XB_SPIN(xb_ld(&bar[XB_TOPGEN]) == tg, bar);
            __builtin_amdgcn_fence(__ATOMIC_ACQUIRE, "agent");
            xb_add(&bar[XB_XGEN(b.x)], 1u);
            asm volatile("s_waitcnt vmcnt(0)" ::: "memory");
        } else {
            XB_SPIN(xb_ld(&bar[XB_XGEN(b.x)]) == gen, bar);
            __builtin_amdgcn_fence(__ATOMIC_ACQUIRE, "agent");
            asm volatile("s_waitcnt vmcnt(0)" ::: "memory");
        }
    }
    __syncthreads();
}

namespace pg8 {
#define PG8_LAS __attribute__((address_space(3)))
typedef unsigned short bf16_t;
typedef short bf16x8 __attribute__((ext_vector_type(8)));
typedef float f32x4 __attribute__((ext_vector_type(4)));
typedef unsigned u32x4 __attribute__((ext_vector_type(4)));
constexpr int BM = 256, BK = 64, HALF = 128, HTB = HALF * BK * 2  , STAGE_BYTES = 8 * HTB, NXCD = 8, WGM = 8;

__host__ __device__ __forceinline__ int lds_byte(int r, int c) { const int st = (r >> 4) * 2 + (c >> 5), rr = r & 15, cc = c & 31, ob = rr * 64 + cc * 2; return st * 1024 + (ob ^ (((ob >> 9) & 1) << 5)); }
__host__ __device__ __forceinline__ void stage_rc(int b, int& R, int& C) { const int st = b / 1024, sb = b % 1024, swz = sb ^ (((sb >> 9) & 1) << 5); R = (st >> 1) * 16 + swz / 64; C = (st & 1) * 32 + (swz % 64) / 2; }
__host__ __device__ __forceinline__ int perm32(int rho) { const int n = rho >> 4, i = rho & 15; return 8 * (i >> 2) + 4 * n + (i & 3); }

struct Unit { int pm, pn; };
struct Gemm { const bf16_t* A; const bf16_t* Bt; int M, N, K; };

struct StaticOrder {
    int nM, nN, nwg, G, c;
    __host__ __device__ void init(int M, int N, int G_, int c_) { nM = M / BM; nN = N / BM; nwg = nM * nN; G = G_; c = c_; }
    __host__ __device__ bool next(int i, Unit& u) const {
        const long L = (long)i * G + c; if (L >= nwg) return false;
        int wgid = (int)L; { const int q = nwg / NXCD, r = nwg % NXCD, xcd = wgid % NXCD, off = wgid / NXCD; wgid = (xcd < r ? xcd * (q + 1) : r * (q + 1) + (xcd - r) * q) + off; }
        const int nig = WGM * nN, gid = wgid / nig, fm = gid * WGM, gsz = (nM - fm) < WGM ? (nM - fm) : WGM;
        u.pm = fm + ((wgid % nig) % gsz); u.pn = (wgid % nig) / gsz; return true;
    }
    __device__ __forceinline__ void a_ready(const Unit&) const {}
    __device__ __forceinline__ void done(const Unit&) const {}
};


__device__ __forceinline__ unsigned cvt_pk_bf16(float lo, float hi) { unsigned r; asm volatile("v_cvt_pk_bf16_f32 %0, %1, %2" : "=v"(r) : "v"(lo), "v"(hi)); return r; }

struct EpiProjFast {
    static constexpr bool PERM = true, AFTER_DRAIN = false;
    bf16_t *QA, *KA, *VA, *SGA, *QB, *KB, *VB, *SGB; float* Gg; const float* b_gate;
    __device__ __forceinline__ void operator()(const f32x4 (&acc)[2][2][4][2], const Unit& u, int wr, int wc, int fr, int fq) const {
        const int pn = u.pn, row0 = u.pm * BM + wr * 64 + fr, col0 = wc * 32 + 8 * fq;
        if (pn == 14) {
            f32x4 bv[2][2];
#pragma unroll
            for (int bj = 0; bj < 2; ++bj)
#pragma unroll
                for (int n = 0; n < 2; ++n) bv[bj][n] = *(const f32x4*)(b_gate + col0 + bj * HALF + 4 * n);
#pragma unroll
            for (int ai = 0; ai < 2; ++ai)
#pragma unroll
                for (int m = 0; m < 4; ++m) { float* rowp = Gg + (size_t)(row0 + ai * HALF + m * 16) * 256 + col0;
#pragma unroll
                    for (int bj = 0; bj < 2; ++bj)
#pragma unroll
                        for (int n = 0; n < 2; ++n) { f32x4 v = acc[ai][bj][m][n] + bv[bj][n];
#pragma unroll
                            for (int e = 0; e < 4; ++e) v[e] = logsigmoid_f(v[e]) * (1.f / 16.f);
                            *(f32x4*)(rowp + bj * HALF + 4 * n) = v; } }
            return;
        }
        bf16_t* base; int ldc = 512, cofs; float sc = 1.f; bool act = false;
        if (pn < 2) { base = QA; cofs = pn * 256; sc = C2; }
        else if (pn < 4) { base = KA; cofs = (pn - 2) * 256; }
        else if (pn < 6) { base = VA; cofs = (pn - 4) * 256; }
        else if (pn < 8) { base = SGA; cofs = (pn - 6) * 256; act = true; }
        else if (pn == 8) { base = QB; ldc = 256; cofs = 0; sc = 0.125f; }
        else if (pn == 9) { base = KB; ldc = 256; cofs = 0; }
        else if (pn < 12) { base = VB; cofs = (pn - 10) * 256; }
        else { base = SGB; cofs = (pn - 12) * 256; act = true; }
#pragma unroll
        for (int ai = 0; ai < 2; ++ai)
#pragma unroll
            for (int m = 0; m < 4; ++m) { bf16_t* rowp = base + (size_t)(row0 + ai * HALF + m * 16) * ldc + cofs + col0;
#pragma unroll
                for (int bj = 0; bj < 2; ++bj) { f32x4 v0 = acc[ai][bj][m][0], v1 = acc[ai][bj][m][1];
                    if (act) {
#pragma unroll
                        for (int e = 0; e < 4; ++e) { v0[e] = v0[e] * __builtin_amdgcn_rcpf(1.f + __expf(-v0[e])); v1[e] = v1[e] * __builtin_amdgcn_rcpf(1.f + __expf(-v1[e])); }
                    } else { v0 = v0 * sc; v1 = v1 * sc; }
                    u32x4 w; w.x = cvt_pk_bf16(v0[0], v0[1]); w.y = cvt_pk_bf16(v0[2], v0[3]); w.z = cvt_pk_bf16(v1[0], v1[1]); w.w = cvt_pk_bf16(v1[2], v1[3]);
                    *(u32x4*)(rowp + bj * HALF) = w; } }
    }
};
struct EpiResFast {
    static constexpr bool PERM = false, AFTER_DRAIN = false;
    const float* x; float* out;
    __device__ __forceinline__ void operator()(const f32x4 (&acc)[2][2][4][2], const Unit& u, int wr, int wc, int fr, int fq) const {
        const int row0 = u.pm * BM + wr * 64 + fr, col0 = u.pn * BM + wc * 32 + 4 * fq;
#pragma unroll
        for (int ai = 0; ai < 2; ++ai)
#pragma unroll
            for (int m = 0; m < 4; ++m) { const size_t off = (size_t)(row0 + ai * HALF + m * 16) * 1024 + col0;
#pragma unroll
                for (int bj = 0; bj < 2; ++bj)
#pragma unroll
                    for (int n = 0; n < 2; ++n) { const size_t i = off + bj * HALF + n * 16; *(f32x4*)(out + i) = *(const f32x4*)(x + i) + acc[ai][bj][m][n]; } }
    }
};
template <class Epi, class Sched, bool ALIGN_EPI = false, bool SP2 = false>
__device__ __forceinline__ void gemm_phase(PG8_LAS unsigned char* lds, const Gemm g, const Sched& S, const Epi& E) {
    const int tid = threadIdx.x, wid = __builtin_amdgcn_readfirstlane(tid >> 6), lane = tid & 63, wr = wid >> 2, wc = wid & 3, fr = lane & 15, fq = lane >> 4;
    const int K = g.K, nt = K / BK;
    unsigned voffA[2], voffB[2];
#pragma unroll
    for (int i = 0; i < 2; ++i) { int R, C; stage_rc(tid * 16 + i * 8192, R, C); const int Rb = Epi::PERM ? ((R & ~31) + perm32(R & 31)) : R;
        voffA[i] = (unsigned)(R * K + C) * 2u; voffB[i] = (unsigned)(Rb * K + C) * 2u; }
    const size_t kstep = (size_t)(BK * 2);
    const size_t hstep = (size_t)HALF * K * 2;
    const size_t tstep = 2 * hstep;
    const unsigned ldsw = (unsigned)wid * 1024u;
    const int aoff = lds_byte(wr * 64 + fr, fq * 8), boff = lds_byte(wc * 32 + fr, fq * 8);
#define PG8_SA(b, h) (((b) * 2 + (h)) * HTB)
#define PG8_SB(b, h) ((4 + (b) * 2 + (h)) * HTB)
#define PG8_STAGE(bufoff, gbase, voff) do { _Pragma("unroll") for (int _i = 0; _i < 2; ++_i) \
        __builtin_amdgcn_global_load_lds((const unsigned*)((const char*)(gbase) + (voff)[_i]), (PG8_LAS unsigned*)(lds + (bufoff) + ldsw + _i * 8192), 16, 0, 0); } while (0)
#define PG8_LDA(dst, b, h) do { _Pragma("unroll") for (int m = 0; m < 4; ++m) _Pragma("unroll") for (int k = 0; k < 2; ++k) dst[m][k] = *(const PG8_LAS bf16x8*)(lds + PG8_SA(b, h) + aoff + m * 2048 + k * 1024); } while (0)
#define PG8_LDB(dst, b, h) do { _Pragma("unroll") for (int n = 0; n < 2; ++n) _Pragma("unroll") for (int k = 0; k < 2; ++k) dst[n][k] = *(const PG8_LAS bf16x8*)(lds + PG8_SB(b, h) + boff + n * 2048 + k * 1024); } while (0)
#define PG8_MMA(ai, bj, At, Bt) do { __builtin_amdgcn_s_setprio(1); _Pragma("unroll") for (int m = 0; m < 4; ++m) _Pragma("unroll") for (int n = 0; n < 2; ++n) _Pragma("unroll") for (int k = 0; k < 2; ++k) \
        acc[ai][bj][m][n] = __builtin_amdgcn_mfma_f32_16x16x32_bf16(Bt[n][k], At[m][k], acc[ai][bj][m][n], 0, 0, 0); __builtin_amdgcn_s_setprio(0); } while (0)
#define PG8_WAIT_V(n) asm volatile("s_waitcnt vmcnt(" #n ")" ::: "memory")
#define PG8_WAIT_L(n) asm volatile("s_waitcnt lgkmcnt(" #n ")" ::: "memory")
#define PG8_BAR __builtin_amdgcn_s_barrier()
#define PG8_SCHED __builtin_amdgcn_sched_barrier(0)
    Unit cur, nxt; int ui = 0;
    if (!S.next(0, cur)) return;
    f32x4 acc[2][2][4][2];
#pragma unroll
    for (int a = 0; a < 2; ++a)
#pragma unroll
        for (int b = 0; b < 2; ++b)
#pragma unroll
            for (int m = 0; m < 4; ++m)
#pragma unroll
                for (int n = 0; n < 2; ++n) acc[a][b][m][n] = (f32x4){0.f, 0.f, 0.f, 0.f};
    bf16x8 At[4][2], B0[2][2], B1[2][2];
    const char* cA = (const char*)g.A + (size_t)cur.pm * tstep; const char* cB = (const char*)g.Bt + (size_t)cur.pn * tstep;
    S.a_ready(cur);
    if constexpr (SP2) {
        PG8_STAGE(PG8_SB(0, 0), cB, voffB); PG8_STAGE(PG8_SB(0, 1), cB + hstep, voffB); PG8_STAGE(PG8_SA(0, 0), cA, voffA); PG8_STAGE(PG8_SA(0, 1), cA + hstep, voffA);
        if (wr == 1) PG8_BAR;
        PG8_WAIT_V(2); PG8_BAR;
        PG8_STAGE(PG8_SB(1, 0), cB + kstep, voffB); PG8_STAGE(PG8_SA(1, 0), cA + kstep, voffA); PG8_STAGE(PG8_SB(1, 1), cB + hstep + kstep, voffB);
        PG8_WAIT_V(6); PG8_BAR;
    } else {
        PG8_STAGE(PG8_SB(0, 0), cB, voffB); PG8_STAGE(PG8_SA(0, 0), cA, voffA); PG8_STAGE(PG8_SB(0, 1), cB + hstep, voffB); PG8_STAGE(PG8_SA(0, 1), cA + hstep, voffA);
        if (wr == 1) PG8_BAR;
        PG8_WAIT_V(4); PG8_BAR;
        PG8_STAGE(PG8_SB(1, 0), cB + kstep, voffB); PG8_STAGE(PG8_SA(1, 0), cA + kstep, voffA); PG8_STAGE(PG8_SB(1, 1), cB + hstep + kstep, voffB);
        PG8_WAIT_V(6); PG8_BAR;
    }
    for (;;) {
        const bool has_next = S.next(ui + 1, nxt);
        const char* nA = has_next ? (const char*)g.A + (size_t)nxt.pm * tstep : cA; const char* nB = has_next ? (const char*)g.Bt + (size_t)nxt.pn * tstep : cB;
        for (int t = 0; t < nt; t += 2) {
            const bool last = (t == nt - 2);
            const char* a1 = cA + (size_t)(t + 1) * kstep;
            const char* a2 = last ? nA : cA + (size_t)(t + 2) * kstep; const char* b2 = last ? nB : cB + (size_t)(t + 2) * kstep;
            const char* a3 = a2 + kstep; const char* b3 = b2 + kstep;
            if (last && has_next) S.a_ready(nxt);
            if constexpr (SP2) {
            PG8_LDB(B0, 0, 0); PG8_LDB(B1, 0, 1); PG8_SCHED; PG8_LDA(At, 0, 0); PG8_STAGE(PG8_SA(1, 1), a1 + hstep, voffA);
            PG8_WAIT_V(8); PG8_WAIT_L(0); PG8_BAR; PG8_MMA(0, 0, At, B0); PG8_MMA(0, 1, At, B1); PG8_BAR; PG8_SCHED;
            PG8_LDA(At, 0, 1); PG8_STAGE(PG8_SB(0, 0), b2, voffB); PG8_STAGE(PG8_SB(0, 1), b2 + hstep, voffB); PG8_STAGE(PG8_SA(0, 0), a2, voffA);
            PG8_WAIT_V(8); PG8_WAIT_L(0); PG8_BAR; PG8_MMA(1, 0, At, B0); PG8_MMA(1, 1, At, B1); PG8_BAR; PG8_SCHED;
            PG8_LDB(B0, 1, 0); PG8_LDB(B1, 1, 1); PG8_SCHED; PG8_LDA(At, 1, 0); PG8_STAGE(PG8_SA(0, 1), a2 + hstep, voffA);
            PG8_WAIT_V(8); PG8_WAIT_L(0); PG8_BAR; PG8_MMA(0, 0, At, B0); PG8_MMA(0, 1, At, B1); PG8_BAR; PG8_SCHED;
            PG8_LDA(At, 1, 1); PG8_STAGE(PG8_SB(1, 0), b3, voffB); PG8_STAGE(PG8_SB(1, 1), b3 + hstep, voffB); PG8_STAGE(PG8_SA(1, 0), a3, voffA);
            PG8_WAIT_V(8); PG8_WAIT_L(0); PG8_BAR; PG8_MMA(1, 0, At, B0); PG8_MMA(1, 1, At, B1); PG8_BAR; PG8_SCHED;
            } else {
            PG8_LDB(B0, 0, 0); PG8_SCHED; PG8_LDA(At, 0, 0); PG8_STAGE(PG8_SA(1, 1), a1 + hstep, voffA);
            PG8_WAIT_L(8); PG8_BAR; PG8_WAIT_L(0); PG8_MMA(0, 0, At, B0); PG8_BAR; PG8_SCHED;
            PG8_LDB(B1, 0, 1); PG8_STAGE(PG8_SB(0, 0), b2, voffB);
            PG8_BAR; PG8_WAIT_L(0); PG8_MMA(0, 1, At, B1); PG8_BAR;
            PG8_LDA(At, 0, 1); PG8_STAGE(PG8_SA(0, 0), a2, voffA);
            PG8_BAR; PG8_WAIT_L(0); PG8_MMA(1, 0, At, B0); PG8_BAR; PG8_SCHED;
            PG8_STAGE(PG8_SB(0, 1), b2 + hstep, voffB);
            PG8_WAIT_V(6); PG8_BAR; PG8_MMA(1, 1, At, B1); PG8_BAR;
            PG8_LDB(B0, 1, 0); PG8_SCHED; PG8_LDA(At, 1, 0); PG8_STAGE(PG8_SA(0, 1), a2 + hstep, voffA);
            PG8_WAIT_L(8); PG8_BAR; PG8_WAIT_L(0); PG8_MMA(0, 0, At, B0); PG8_BAR; PG8_SCHED;
            PG8_LDB(B1, 1, 1); PG8_STAGE(PG8_SB(1, 0), b3, voffB);
            PG8_BAR; PG8_WAIT_L(0); PG8_MMA(0, 1, At, B1); PG8_BAR;
            PG8_LDA(At, 1, 1); PG8_STAGE(PG8_SA(1, 0), a3, voffA);
            PG8_BAR; PG8_WAIT_L(0); PG8_MMA(1, 0, At, B0); PG8_BAR; PG8_SCHED;
            PG8_STAGE(PG8_SB(1, 1), b3 + hstep, voffB);
            PG8_WAIT_V(6); PG8_BAR; PG8_MMA(1, 1, At, B1); PG8_BAR;
            }
        }
        if constexpr (ALIGN_EPI) { if (wr == 0) PG8_BAR; }
        if constexpr (!Epi::AFTER_DRAIN) { E(acc, cur, wr, wc, fr, fq); S.done(cur); }
        if (!has_next) break;
#pragma unroll
        for (int a = 0; a < 2; ++a)
#pragma unroll
            for (int b = 0; b < 2; ++b)
#pragma unroll
                for (int m = 0; m < 4; ++m)
#pragma unroll
                    for (int n = 0; n < 2; ++n) acc[a][b][m][n] = (f32x4){0.f, 0.f, 0.f, 0.f};
        cur = nxt; cA = nA; cB = nB; ++ui;
        if constexpr (ALIGN_EPI) { if (wr == 1) PG8_BAR; }
    }
    PG8_WAIT_V(0);
    if constexpr (!ALIGN_EPI) { if (wr == 0) PG8_BAR; }
    PG8_BAR;
    if constexpr (Epi::AFTER_DRAIN) { E.fused(acc, cur, wr, wc, fr, fq, lds, wid, lane); S.done(cur); }
#undef PG8_SA
#undef PG8_SB
#undef PG8_STAGE
#undef PG8_LDA
#undef PG8_LDB
#undef PG8_MMA
#undef PG8_WAIT_V
#undef PG8_WAIT_L
#undef PG8_BAR
#undef PG8_SCHED
}
}

struct Frame {
    LAS unsigned char* lds;
    volatile LAS unsigned* MISC;
    gu32* ctl;
    int tid, lane, wave, vcu, G;
    const float *x, *norm_w, *w_in, *w_gate_up, *b_gate, *lq1, *lk1, *lq2, *lk2, *subln_w, *gla_w, *w_out, *fin_w;
    float* out;
    bf16 *Win_t, *Wout_t, *XN, *Y, *QA, *KA, *VA, *SGA, *QB, *KB, *VB, *SGB;
    float *Gg, *O1, *GST;
};
__device__ __forceinline__ float wave_sum(float v) {
#pragma unroll
    for (int o = 1; o < 64; o <<= 1) v += __shfl_xor(v, o);
    return v;
}

__device__ __forceinline__ void p0_transpose_item(const float* W, int K, int ldw, int nblk, const float* ks, bf16* WT, int row_off, LAS float* scr, int item, int lane) {
    const int kb = item / nblk, nb = item % nblk, k0 = 64 * kb, n0 = 32 * nb;
#pragma unroll 8
    for (int i = 0; i < 32; ++i) { const int kk = 2 * i + (lane >> 5); float v = W[(size_t)(k0 + kk) * ldw + n0 + (lane & 31)]; if (ks) v *= ks[k0 + kk]; scr[kk * 33 + (lane & 31)] = v; }
    LDS_WAIT(); asm volatile("" ::: "memory");
    const int c = lane & 7;
#pragma unroll
    for (int j = 0; j < 4; ++j) { const int n = (lane >> 3) + 8 * j; const LAS float* s = scr + (8 * c) * 33 + n;
        v4u o; o.x = pk2(s[0 * 33], s[1 * 33]); o.y = pk2(s[2 * 33], s[3 * 33]); o.z = pk2(s[4 * 33], s[5 * 33]); o.w = pk2(s[6 * 33], s[7 * 33]);
        *(GAS v4u*)(WT + (size_t)(row_off + n0 + n) * K + k0 + 8 * c) = o; }
    LDS_WAIT(); asm volatile("" ::: "memory");
}
__device__ __forceinline__ void rms_row_to_bf16(Frame& F, const float* xrow, bf16* orow) {
    const GAS f32x4* xr = (const GAS f32x4*)xrow + F.lane;
    f32x4 v[4]; float s = 0.f;
#pragma unroll
    for (int j = 0; j < 4; ++j) { v[j] = xr[64 * j]; s += (v[j].x * v[j].x + v[j].y * v[j].y) + (v[j].z * v[j].z + v[j].w * v[j].w); }
    const float rstd = 1.f / sqrtf(wave_sum(s) * (1.f / D) + EPS);
    GAS unsigned long long* o8 = (GAS unsigned long long*)orow + F.lane;
#pragma unroll
    for (int j = 0; j < 4; ++j) o8[64 * j] = (unsigned long long)pk2(v[j].x * rstd, v[j].y * rstd) | ((unsigned long long)pk2(v[j].z * rstd, v[j].w * rstd) << 32);
}
__device__ __forceinline__ void p0_prologue(Frame& F) {
    LAS float* scr = (LAS float*)(F.lds + F.wave * 16384);
    const int gw = F.vcu * NWAVES + F.wave, NGW = F.G * NWAVES;
    constexpr int I_IN = (D / 64) * (3584 / 32), I_OUT = (D / 64) * (D / 32);
    for (int it = gw; it < I_IN + I_OUT; it += NGW) {
        if (it < I_IN) p0_transpose_item(F.w_in, D, IN_COLS, 3584 / 32, F.norm_w, F.Win_t, 0, scr, it, F.lane);
        else p0_transpose_item(F.w_out, D, D, D / 32, nullptr, F.Wout_t, 0, scr, it - I_IN, F.lane);
    }
    const int gt = (F.vcu * NWAVES + F.wave) * 64 + F.lane, NGT = NGW * 64;
    for (int it = gt; it < 256 * (D / 8); it += NGT) {
        const int j = it / (D / 8), k0 = (it % (D / 8)) * 8;
        float wg[16];
#pragma unroll
        for (int r = 0; r < 16; ++r) wg[r] = F.w_gate_up[r * 256 + j];
        float o[8];
#pragma unroll
        for (int i = 0; i < 8; ++i) { const float* wr = F.w_in + (size_t)(k0 + i) * IN_COLS + 3584; float a = 0.f;
#pragma unroll
            for (int r = 0; r < 16; ++r) a += wr[r] * wg[r];
            o[i] = a * F.norm_w[k0 + i]; }
        v4u w; w.x = pk2(o[0], o[1]); w.y = pk2(o[2], o[3]); w.z = pk2(o[4], o[5]); w.w = pk2(o[6], o[7]);
        *(GAS v4u*)(F.Win_t + (size_t)(3584 + j) * D + k0) = w;
    }
    for (int m = gw; m < M; m += NGW) rms_row_to_bf16(F, F.x + (size_t)m * D, F.XN + (size_t)m * D);
}

__device__ __forceinline__ float lambda_full(Frame& F) {
    float s1 = 0.f, s2 = 0.f;
    for (int i = 0; i < 64; ++i) { s1 += F.lq1[i] * F.lk1[i]; s2 += F.lq2[i] * F.lk2[i]; }
    return __expf(s1) - __expf(s2) + LAM_INIT;
}
__device__ __forceinline__ void simple_attn(Frame& F) {
    LAS float* Ks = (LAS float*)F.lds;
    LAS float* Vs = Ks + 64 * 64;
    const int tid = F.tid;
    const float lam = lambda_full(F);
    for (int u = blockIdx.x; u < 256; u += gridDim.x) {
        const int b = u >> 5, h = (u >> 3) & 3, p = u & 7;
        const float slope2 = exp2f(-2.f * (float)(h + 1)) * LOG2E;
        for (int half = 0; half < 2; ++half) {
            const int rb = half ? 15 - p : p;
            const int row = rb * 512 + tid;
            const size_t grow = (size_t)b * T + row;
            const int ntiles = (rb * 512 + 512) / 64;
            float ssq = 0.f;
            float* o1 = F.O1 + grow * 512 + h * 128;
            for (int pass = 0; pass < 4; ++pass) {
                const int sub = pass >> 1, eh = pass & 1;
                unsigned qw[32];
                { const GAS v4u* qp = (const GAS v4u*)(F.QA + grow * 512 + h * 128 + sub * 64);
#pragma unroll
                  for (int i = 0; i < 8; ++i) { const v4u w = qp[i]; qw[4 * i] = w.x; qw[4 * i + 1] = w.y; qw[4 * i + 2] = w.z; qw[4 * i + 3] = w.w; } }
                float mx = -1e30f, l = 0.f; float o[64];
#pragma unroll
                for (int e = 0; e < 64; ++e) o[e] = 0.f;
                for (int kt = 0; kt < ntiles; ++kt) {
                    __syncthreads();
                    { const int key = tid >> 3, seg = (tid & 7) * 8; const size_t kr = (size_t)b * T + kt * 64 + key;
                      const v4u w = *(const GAS v4u*)(F.KA + kr * 512 + h * 128 + sub * 64 + seg);
                      LAS float* d = Ks + key * 64 + seg; d[0] = bflo(w.x); d[1] = bfhi(w.x); d[2] = bflo(w.y); d[3] = bfhi(w.y); d[4] = bflo(w.z); d[5] = bfhi(w.z); d[6] = bflo(w.w); d[7] = bfhi(w.w);
                      const v4u x = *(const GAS v4u*)(F.VA + kr * 512 + h * 128 + eh * 64 + seg);
                      LAS float* e = Vs + key * 64 + seg; e[0] = bflo(x.x); e[1] = bfhi(x.x); e[2] = bflo(x.y); e[3] = bfhi(x.y); e[4] = bflo(x.z); e[5] = bfhi(x.z); e[6] = bflo(x.w); e[7] = bfhi(x.w); }
                    __syncthreads();
                    const int jn = row - kt * 64;
                    for (int j = 0; j < 64; ++j) {
                        if (j > jn) break;
                        float s = 0.f;
#pragma unroll
                        for (int dd = 0; dd < 32; ++dd) { s += bflo(qw[dd]) * Ks[j * 64 + 2 * dd]; s += bfhi(qw[dd]) * Ks[j * 64 + 2 * dd + 1]; }
                        s -= slope2 * (float)(jn - j);
                        if (s > mx) { const float al = exp2f(mx - s); l *= al;
#pragma unroll
                            for (int e = 0; e < 64; ++e) o[e] *= al;
                            mx = s; }
                        const float pp = exp2f(s - mx); l += pp;
#pragma unroll
                        for (int e = 0; e < 64; ++e) o[e] += pp * Vs[j * 64 + e];
                    }
                }
                const float rl = 1.f / l;
                if (sub == 0) {
#pragma unroll
                    for (int e = 0; e < 64; e += 4) *(GAS f32x4*)(o1 + eh * 64 + e) = (f32x4){o[e] * rl, o[e + 1] * rl, o[e + 2] * rl, o[e + 3] * rl};
                } else {
#pragma unroll
                    for (int e = 0; e < 64; e += 4) { const f32x4 a = *(const GAS f32x4*)(o1 + eh * 64 + e);
                        const f32x4 dv = (f32x4){a.x - lam * o[e] * rl, a.y - lam * o[e + 1] * rl, a.z - lam * o[e + 2] * rl, a.w - lam * o[e + 3] * rl};
                        ssq += (dv.x * dv.x + dv.y * dv.y) + (dv.z * dv.z + dv.w * dv.w);
                        *(GAS f32x4*)(o1 + eh * 64 + e) = dv; }
                }
            }
            {
                const float rstd = (1.f - LAM_INIT) / sqrtf(ssq * (1.f / 128.f) + EPS);
                const bf16* sg = F.SGA + grow * 512 + h * 128; bf16* y = F.Y + grow * 1024 + h * 128;
                for (int e = 0; e < 128; e += 8) { const v4u g = *(const GAS v4u*)(sg + e); const f32x4 a0 = *(const GAS f32x4*)(o1 + e), a1 = *(const GAS f32x4*)(o1 + e + 4); v4u w;
                    w.x = pk2(a0.x * rstd * F.subln_w[e] * bflo(g.x), a0.y * rstd * F.subln_w[e + 1] * bfhi(g.x));
                    w.y = pk2(a0.z * rstd * F.subln_w[e + 2] * bflo(g.y), a0.w * rstd * F.subln_w[e + 3] * bfhi(g.y));
                    w.z = pk2(a1.x * rstd * F.subln_w[e + 4] * bflo(g.z), a1.y * rstd * F.subln_w[e + 5] * bfhi(g.z));
                    w.w = pk2(a1.z * rstd * F.subln_w[e + 6] * bflo(g.w), a1.w * rstd * F.subln_w[e + 7] * bfhi(g.w));
                    *(GAS v4u*)(y + e) = w; }
            }
        }
    }
    __syncthreads();
}

namespace da {
typedef short bf16x8 __attribute__((ext_vector_type(8)));
typedef short s16x4 __attribute__((ext_vector_type(4)));
typedef float f32x16 __attribute__((ext_vector_type(16)));
typedef unsigned u32x4 __attribute__((ext_vector_type(4)));
constexpr int NW = 8, QBLK = 32, KVBLK = 64, QB = NW * QBLK;
constexpr int SHM_V = KVBLK * 128 * 2, SHM_K = KVBLK * 64 * 2;
constexpr int ATT_LDS = 2 * SHM_V + 2 * SHM_K + NW * 64 * 4;
constexpr int PQ = 512, PK = 512, PV = 512;
constexpr float THR2 = 8.f;
#define DA_KSWZ(row, colB) ((row) * 128 + ((colB) ^ ((((row) >> 1) & 7) << 4)))
#define DA_SBAR() __builtin_amdgcn_sched_barrier(0)
__device__ __forceinline__ int v_st(int k, int c) { const int kk = (k & ~0xC) | ((k & 4) << 1) | ((k & 8) >> 1); return ((kk >> 3) * 4 + (c >> 5)) * 512 + ((kk & 7) * 32 + (c & 31)) * 2; }
__device__ __forceinline__ int v_rd_base(int lane) { return ((lane & 3) << 3) | (((lane >> 2) & 3) << 6) | (((lane >> 4) & 1) << 5) | (((lane >> 5) & 1) << 8); }
constexpr int v_rd_off(int d0, int ks, int half) { return d0 * 512 + ks * 4096 + half * 2048; }
__device__ __forceinline__ int crow(int r, int hi) { return (r & 3) + 8 * (r >> 2) + 4 * hi; }
__device__ __forceinline__ unsigned cvtpk(float lo, float hi) { unsigned r; asm volatile("v_cvt_pk_bf16_f32 %0, %1, %2" : "=v"(r) : "v"(lo), "v"(hi)); return r; }
__device__ __forceinline__ void mask_tile(f32x16& p0, f32x16& p1, int dq) {
    const float NEG = -__builtin_inff();
#pragma unroll
    for (int r = 0; r < 16; ++r) { const int c = (r & 3) + 8 * (r >> 2); if (c > dq) p0[r] = NEG; if (c + 32 > dq) p1[r] = NEG; }
}
__device__ __forceinline__ void partialSM(f32x16& p0, f32x16& p1, float& m_reg, float& alpha) {
    float pmax = p0[0];
#pragma unroll
    for (int r = 1; r < 16; ++r) pmax = fmaxf(pmax, p0[r]);
#pragma unroll
    for (int r = 0; r < 16; ++r) pmax = fmaxf(pmax, p1[r]);
    { auto rr = __builtin_amdgcn_permlane32_swap(__float_as_uint(pmax), __float_as_uint(pmax), false, false);
      pmax = fmaxf(__uint_as_float(rr[0]), __uint_as_float(rr[1])); }
    float mn;
    if (__builtin_expect(__all(pmax - m_reg <= THR2), 1)) { mn = m_reg; alpha = 1.f; }
    else { mn = fmaxf(m_reg, pmax); alpha = __builtin_amdgcn_exp2f(m_reg - mn); m_reg = mn; }
#pragma unroll
    for (int r = 0; r < 16; ++r) { p0[r] -= mn; p1[r] -= mn; }
#pragma unroll
    for (int r = 0; r < 16; ++r) p0[r] = __builtin_amdgcn_exp2f(p0[r]);
}
__device__ __forceinline__ void finishSM(f32x16& p0, f32x16& p1, float alpha, float& l_reg, bf16x8& pa0, bf16x8& pa1, bf16x8& pa2, bf16x8& pa3) {
#pragma unroll
    for (int r = 0; r < 16; ++r) p1[r] = __builtin_amdgcn_exp2f(p1[r]);
    float ps = 0;
#pragma unroll
    for (int r = 0; r < 16; ++r) ps += p0[r];
#pragma unroll
    for (int r = 0; r < 16; ++r) ps += p1[r];
    { auto rr = __builtin_amdgcn_permlane32_swap(__float_as_uint(ps), __float_as_uint(ps), false, false);
      ps = __uint_as_float(rr[0]) + __uint_as_float(rr[1]); }
    l_reg = l_reg * alpha + ps;
#define DA_PK4(P, B_, OUT) do { unsigned a0 = cvtpk(P[B_+0], P[B_+1]), a1 = cvtpk(P[B_+2], P[B_+3]);                          \
        unsigned b0 = cvtpk(P[B_+4], P[B_+5]), b1 = cvtpk(P[B_+6], P[B_+7]);                                             \
        auto r0 = __builtin_amdgcn_permlane32_swap(a0, b0, false, false); auto r1 = __builtin_amdgcn_permlane32_swap(a1, b1, false, false); \
        u32x4 w = {r0[0], r1[0], r0[1], r1[1]}; OUT = *reinterpret_cast<bf16x8*>(&w); } while (0)
    DA_PK4(p0, 0, pa0); DA_PK4(p0, 8, pa1); DA_PK4(p1, 0, pa2); DA_PK4(p1, 8, pa3);
#undef DA_PK4
}
template <int KB>
__device__ __forceinline__ void qkt(f32x16& p0, f32x16& p1, const char* K_lds, int r32, int hi, const bf16x8* qr, float bias0, float slope2) {
#pragma unroll
    for (int r = 0; r < 16; ++r) { const float c = (float)((r & 3) + 8 * (r >> 2)); p0[r] = fmaf(slope2, c, bias0); p1[r] = fmaf(slope2, c + 32.f, bias0); }
    const char* kb[4];
#pragma unroll
    for (int dd = 0; dd < 4; ++dd) kb[dd] = K_lds + KB * SHM_K + DA_KSWZ(r32, (dd * 16 + hi * 8) * 2);
#pragma unroll
    for (int d0 = 0; d0 < 4; ++d0) {
        bf16x8 b0 = *reinterpret_cast<const bf16x8*>(kb[d0]);
        bf16x8 b1 = *reinterpret_cast<const bf16x8*>(kb[d0] + 32 * 128);
        p0 = __builtin_amdgcn_mfma_f32_32x32x16_bf16(b0, qr[d0], p0, 0, 0, 0);
        p1 = __builtin_amdgcn_mfma_f32_32x32x16_bf16(b1, qr[d0], p1, 0, 0, 0); }
}
template <int VB>
__device__ __forceinline__ void pv_tile(f32x16* o, int vb0, bf16x8 pa0, bf16x8 pa1, bf16x8 pa2, bf16x8 pa3) {
#define DA_TRRD(dst, off) asm volatile("ds_read_b64_tr_b16 %0, %1 offset:%2" : "=&v"(dst) : "v"(vb0), "i"(off) : "memory")
#define DA_PV_D0(d0) do { s16x4 l0, l1, l2, l3, h0, h1, h2, h3; constexpr int b_ = VB * SHM_V + v_rd_off(d0, 0, 0); \
        DA_TRRD(l0, b_); DA_TRRD(h0, b_ + 2048); DA_TRRD(l1, b_ + 4096); DA_TRRD(h1, b_ + 6144); DA_TRRD(l2, b_ + 8192); DA_TRRD(h2, b_ + 10240); DA_TRRD(l3, b_ + 12288); DA_TRRD(h3, b_ + 14336); \
        asm volatile("s_waitcnt lgkmcnt(0)" ::: "memory"); DA_SBAR();   \
        o[d0] = __builtin_amdgcn_mfma_f32_32x32x16_bf16(pa0, (bf16x8){l0[0], l0[1], l0[2], l0[3], h0[0], h0[1], h0[2], h0[3]}, o[d0], 0, 0, 0);   \
        o[d0] = __builtin_amdgcn_mfma_f32_32x32x16_bf16(pa1, (bf16x8){l1[0], l1[1], l1[2], l1[3], h1[0], h1[1], h1[2], h1[3]}, o[d0], 0, 0, 0);   \
        o[d0] = __builtin_amdgcn_mfma_f32_32x32x16_bf16(pa2, (bf16x8){l2[0], l2[1], l2[2], l2[3], h2[0], h2[1], h2[2], h2[3]}, o[d0], 0, 0, 0);   \
        o[d0] = __builtin_amdgcn_mfma_f32_32x32x16_bf16(pa3, (bf16x8){l3[0], l3[1], l3[2], l3[3], h3[0], h3[1], h3[2], h3[3]}, o[d0], 0, 0, 0); } while (0)
    DA_PV_D0(0); DA_PV_D0(1); DA_PV_D0(2); DA_PV_D0(3);
#undef DA_PV_D0
#undef DA_TRRD
}
struct BlockRef { const bf16* Q; const bf16* K; const bf16* V; float* O1; bf16* Y; const bf16* SG; int P0; int sub; float slope2; int jlo; };
struct Seam { bf16x8 qr[4]; bf16x8 st_v0, st_v1, st_k0; };
struct Consts { float lam; const float* subln_w; };
#define DA_VMW() asm volatile("s_waitcnt vmcnt(0)" ::: "memory")
#define DA_VMWN(n) asm volatile("s_waitcnt vmcnt(%0)" :: "i"(n) : "memory")
#define DA_SLOAD(Kp, Vp, k0) do { S.st_v0 = *reinterpret_cast<const bf16x8*>((Vp) + (size_t)((k0) + sr) * PV + sc); S.st_v1 = *reinterpret_cast<const bf16x8*>((Vp) + (size_t)((k0) + 32 + sr) * PV + sc); \
                                  S.st_k0 = *reinterpret_cast<const bf16x8*>((Kp) + (size_t)((k0) + ksr) * PK + ksc); } while (0)
#define DA_SWRITE_K(bf) do { *(bf16x8*)(K_lds + (bf) * SHM_K + kws) = S.st_k0; } while (0)
#define DA_SWRITE_V(bf) do { *(bf16x8*)(V_lds + (bf) * SHM_V + vst0) = S.st_v0; *(bf16x8*)(V_lds + (bf) * SHM_V + vst1) = S.st_v1; } while (0)
__device__ __forceinline__ void prime(const BlockRef& cur, char* lds, Seam& S) {
    const int tid = threadIdx.x, wid = __builtin_amdgcn_readfirstlane(tid >> 6), lane = tid & 63, r32 = lane & 31, hi = lane >> 5;
    const int sr = tid >> 4, sc = (tid & 15) * 8, ksr = tid >> 3, ksc = (tid & 7) * 8, kws = DA_KSWZ(ksr, ksc * 2); char* K_lds = lds + 2 * SHM_V;
    const int kb0 = cur.jlo * KVBLK;
#pragma unroll
    for (int d0 = 0; d0 < 4; ++d0) S.qr[d0] = *reinterpret_cast<const bf16x8*>(cur.Q + (size_t)(wid * QBLK + r32) * PQ + d0 * 16 + hi * 8);
    DA_SLOAD(cur.K, cur.V, kb0); DA_VMW(); DA_SWRITE_K(0);
    __syncthreads();
}
__device__ __forceinline__ void block(const BlockRef& cur, const BlockRef& nxt, char* lds, Seam& S, const Consts& C) {
    const int tid = threadIdx.x, wid = __builtin_amdgcn_readfirstlane(tid >> 6), lane = tid & 63, r32 = lane & 31, hi = lane >> 5;
    const int j_lo = cur.jlo, j_hi = (cur.P0 + QB - 1) / KVBLK + 1;
    const int NT = j_hi - j_lo;
    const int kbn = nxt.jlo * KVBLK;
    const int qlo = cur.P0 + wid * QBLK, qm = qlo + r32 - 4 * hi;
    char* V_lds = lds; char* K_lds = lds + 2 * SHM_V;
    float* ws = (float*)(lds + 2 * SHM_V + 2 * SHM_K) + wid * 64; float* li_l = ws, * al_l = ws + 32;
    float m_reg = -1e30f, l_reg = 0; f32x16 o[4] = {};
    const int sr = tid >> 4, sc = (tid & 15) * 8, vst0 = v_st(sr, sc), vst1 = v_st(32 + sr, sc), ksr = tid >> 3, ksc = (tid & 7) * 8, kws = DA_KSWZ(ksr, ksc * 2);
    const int vb0 = (int)(uintptr_t)V_lds + v_rd_base(lane);
    const bf16* Kh = cur.K; const bf16* Vh = cur.V;
    const float slope2 = cur.slope2;
#define DA_RESC(a) do { if (__any((a) < 1.f)) { if (hi == 0) al_l[r32] = (a); asm volatile("s_waitcnt lgkmcnt(0)" ::: "memory");              \
                     for (int d_ = 0; d_ < 4; ++d_) for (int r = 0; r < 16; ++r) o[d_][r] *= al_l[crow(r, hi)]; } } while (0)
#define DA_KBASE(t) ((j_lo + (t)) * KVBLK)
#define DA_BIAS(t) (slope2 * (float)(DA_KBASE(t) - cur.P0 + 4 * hi))
#define DA_MASKT(P0_, P1_, t) do { const int kb_ = DA_KBASE(t); if (kb_ + KVBLK - 1 > qlo) mask_tile(P0_, P1_, qm - kb_); } while (0)
    f32x16 pA0, pA1, pB0, pB1; float alA, alB; bf16x8 pa0, pa1, pa2, pa3;
    DA_SWRITE_V(0); DA_SBAR();
    if (NT > 1) DA_SLOAD(Kh, Vh, DA_KBASE(1));
    DA_SBAR(); qkt<0>(pA0, pA1, K_lds, r32, hi, S.qr, DA_BIAS(0), slope2);
    DA_MASKT(pA0, pA1, 0); partialSM(pA0, pA1, m_reg, alA);
    if (NT > 1) { DA_VMW(); DA_SWRITE_V(1); DA_SWRITE_K(1); }
    __syncthreads();
#define DA_HALF_STEP(PX0, PX1, alX, PY0, PY1, alY, t, KB, VB, SB) do {                                         \
        DA_SBAR(); qkt<KB>(PX0, PX1, K_lds, r32, hi, S.qr, DA_BIAS(t), slope2);                                  \
        finishSM(PY0, PY1, alY, l_reg, pa0, pa1, pa2, pa3); DA_SBAR();                                           \
        if ((t) + 1 < NT) { DA_SLOAD(Kh, Vh, DA_KBASE((t) + 1)); DA_SBAR(); }                                    \
        pv_tile<VB>(o, vb0, pa0, pa1, pa2, pa3); DA_MASKT(PX0, PX1, (t)); partialSM(PX0, PX1, m_reg, alX);       \
        __syncthreads();                                                                                         \
        if ((t) + 1 < NT) { DA_VMW(); DA_SWRITE_V(SB); DA_SWRITE_K(SB); }                                        \
        DA_RESC(alX); __syncthreads(); } while (0)
    for (int t = 1; t + 1 < NT; t += 2) {
        DA_HALF_STEP(pB0, pB1, alB, pA0, pA1, alA, t, 1, 0, 0);
        DA_HALF_STEP(pA0, pA1, alA, pB0, pB1, alB, t + 1, 0, 1, 1);
    }
    const bool even = (NT & 1) == 0;
    if (even) { DA_SBAR(); qkt<1>(pB0, pB1, K_lds, r32, hi, S.qr, DA_BIAS(NT - 1), slope2); DA_SBAR(); }
    DA_SLOAD(nxt.K, nxt.V, kbn); DA_SBAR();
#pragma unroll
    for (int d0 = 0; d0 < 4; ++d0) S.qr[d0] = *reinterpret_cast<const bf16x8*>(nxt.Q + (size_t)(wid * QBLK + r32) * PQ + d0 * 16 + hi * 8);
    DA_SBAR();
    finishSM(pA0, pA1, alA, l_reg, pa0, pa1, pa2, pa3); DA_SBAR();
    pv_tile<0>(o, vb0, pa0, pa1, pa2, pa3);
    if (even) { DA_MASKT(pB0, pB1, NT - 1); partialSM(pB0, pB1, m_reg, alB); __syncthreads(); DA_RESC(alB);
        finishSM(pB0, pB1, alB, l_reg, pa0, pa1, pa2, pa3); DA_SBAR(); pv_tile<1>(o, vb0, pa0, pa1, pa2, pa3); }
    DA_SBAR(); DA_VMWN(4); DA_SWRITE_K(0); DA_SBAR();
    if (hi == 0) li_l[r32] = l_reg; asm volatile("s_waitcnt lgkmcnt(0)" ::: "memory");
    float rli[16];
#pragma unroll
    for (int r = 0; r < 16; ++r) rli[r] = __builtin_amdgcn_rcpf(li_l[crow(r, hi)]);
    float* stg = (float*)(lds + ATT_LDS) + wid * 2048;
    int srow = lane >> 4, scol = (lane & 15) * 4;
    asm volatile("" : "+v"(srow), "+v"(scol));
    typedef float f32x4e __attribute__((ext_vector_type(4)));
    typedef unsigned u32x2e __attribute__((ext_vector_type(2)));
    float* gO = cur.O1 + (size_t)(wid * QBLK + srow) * 512 + scol;
    if (cur.sub == 0) {
#pragma unroll
        for (int hf = 0; hf < 2; ++hf) {
#pragma unroll
            for (int r = 0; r < 16; ++r)
#pragma unroll
                for (int dd = 0; dd < 2; ++dd) stg[crow(r, hi) * 64 + dd * 32 + r32] = o[2 * hf + dd][r] * rli[r];
            asm volatile("s_waitcnt lgkmcnt(0)" ::: "memory");
#pragma unroll
            for (int i = 0; i < 8; ++i) { const f32x4e v = *(const f32x4e*)(stg + (i * 4 + srow) * 64 + scol); *(f32x4e*)(gO + (size_t)i * 4 * 512 + hf * 64) = v; }
            asm volatile("s_waitcnt lgkmcnt(0)" ::: "memory");
        }
    } else {
        const float lam = C.lam; f32x4e dv[2][8]; float ssq[8];
#pragma unroll
        for (int i = 0; i < 8; ++i) ssq[i] = 0.f;
#pragma unroll
        for (int hf = 0; hf < 2; ++hf) {
#pragma unroll
            for (int r = 0; r < 16; ++r)
#pragma unroll
                for (int dd = 0; dd < 2; ++dd) stg[crow(r, hi) * 64 + dd * 32 + r32] = o[2 * hf + dd][r] * rli[r];
            asm volatile("s_waitcnt lgkmcnt(0)" ::: "memory");
#pragma unroll
            for (int i = 0; i < 8; ++i) { const f32x4e v = *(const f32x4e*)(stg + (i * 4 + srow) * 64 + scol); const f32x4e a = *(const f32x4e*)(gO + (size_t)i * 4 * 512 + hf * 64);
                const f32x4e d4 = a - lam * v; dv[hf][i] = d4; ssq[i] += (d4.x * d4.x + d4.y * d4.y) + (d4.z * d4.z + d4.w * d4.w); }
            asm volatile("s_waitcnt lgkmcnt(0)" ::: "memory");
        }
#pragma unroll
        for (int i = 0; i < 8; ++i) { float q = ssq[i]; q += __shfl_xor(q, 1); q += __shfl_xor(q, 2); q += __shfl_xor(q, 4); q += __shfl_xor(q, 8);
            ssq[i] = (1.f - LAM_INIT) * __builtin_amdgcn_rsqf(q * (1.f / 128.f) + EPS); }
        const bf16* sg = cur.SG + (size_t)(wid * QBLK + srow) * 512 + scol; bf16* yw = cur.Y + (size_t)(wid * QBLK + srow) * 1024 + scol;
#pragma unroll
        for (int hf = 0; hf < 2; ++hf) { const f32x4e gw = *(const f32x4e*)(C.subln_w + hf * 64 + scol);
#pragma unroll
            for (int i = 0; i < 8; ++i) { const u32x2e g = *(const u32x2e*)(sg + (size_t)i * 4 * 512 + hf * 64); const f32x4e d4 = dv[hf][i] * ssq[i] * gw; u32x2e w;
                w.x = cvtpk(d4.x * bflo(g.x), d4.y * bfhi(g.x)); w.y = cvtpk(d4.z * bflo(g.y), d4.w * bfhi(g.y));
                *(u32x2e*)(yw + (size_t)i * 4 * 1024 + hf * 64) = w; } }
    }
    __syncthreads();
#undef DA_RESC
#undef DA_KBASE
#undef DA_BIAS
#undef DA_MASKT
#undef DA_HALF_STEP
}
}

__device__ __forceinline__ void simple_gla(Frame& F) {
    LAS float* S = (LAS float*)F.lds;
    LAS float* Qi = S + 8192;
    LAS float* Ki = Qi + 4096;
    LAS float* Kst = Ki + 4096;
    LAS float* Vv = Kst + 4096;
    LAS float* Aa = Vv + 8192;
    LAS float* wtot = Aa + 4096;
    LAS float* dec = wtot + 512;
    const int tid = F.tid, d = tid & 63, w = tid >> 6;
    for (int u = blockIdx.x; u < BATCH * H; u += gridDim.x) {
        const int b = u / H, h = u % H;
        __syncthreads();
        for (int i = tid; i < 8192; i += 512) S[i] = 0.f;
        for (int n = 0; n < T / 64; ++n) {
            const size_t tok0 = (size_t)b * T + n * 64;
            float gl[8]; float run = 0.f;
#pragma unroll
            for (int i = 0; i < 8; ++i) { run += F.Gg[(tok0 + 8 * w + i) * 256 + h * 64 + d]; gl[i] = run; }
            __syncthreads();
            wtot[w * 64 + d] = run;
            __syncthreads();
            float off = 0.f, tot = 0.f;
#pragma unroll
            for (int ww = 0; ww < 8; ++ww) { const float v = wtot[ww * 64 + d]; tot += v; if (ww < w) off += v; }
#pragma unroll
            for (int i = 0; i < 8; ++i) { const int t = 8 * w + i; const float bb = gl[i] + off;
                const float qv = bf2f(F.QB[(tok0 + t) * 256 + h * 64 + d]), kv = bf2f(F.KB[(tok0 + t) * 256 + h * 64 + d]);
                Qi[t * 64 + d] = qv * __expf(bb); Ki[t * 64 + d] = kv * __expf(-bb); Kst[t * 64 + d] = kv * __expf(tot - bb); }
            if (w == 0) dec[d] = __expf(tot);
            { const int t = tid >> 3, seg = (tid & 7) * 16;
#pragma unroll
              for (int q2 = 0; q2 < 2; ++q2) { const v4u x = *(const GAS v4u*)(F.VB + (tok0 + t) * 512 + h * 128 + seg + q2 * 8);
                LAS float* e = Vv + t * 128 + seg + q2 * 8; e[0] = bflo(x.x); e[1] = bfhi(x.x); e[2] = bflo(x.y); e[3] = bfhi(x.y); e[4] = bflo(x.z); e[5] = bfhi(x.z); e[6] = bflo(x.w); e[7] = bfhi(x.w); } }
            __syncthreads();
            { const int c = tid >> 3, s0 = (tid & 7) * 8;
#pragma unroll
              for (int si = 0; si < 8; ++si) { const int s = s0 + si; float a = 0.f;
                  for (int dd = 0; dd < 64; ++dd) a += Qi[c * 64 + dd] * Ki[s * 64 + dd];
                  Aa[c * 64 + s] = (s <= c) ? a : 0.f; } }
            __syncthreads();
            { const int c = tid >> 3, e0 = (tid & 7) * 16; float o[16];
#pragma unroll
              for (int i = 0; i < 16; ++i) o[i] = 0.f;
              for (int s = 0; s < 64; ++s) { const float a = Aa[c * 64 + s], qv = Qi[c * 64 + s];
#pragma unroll
                  for (int i = 0; i < 16; ++i) o[i] += a * Vv[s * 128 + e0 + i] + qv * S[s * 128 + e0 + i]; }
              float ssq = 0.f;
#pragma unroll
              for (int i = 0; i < 16; ++i) ssq += o[i] * o[i];
              ssq += __shfl_xor(ssq, 1); ssq += __shfl_xor(ssq, 2); ssq += __shfl_xor(ssq, 4);
              const float rstd = 1.f / sqrtf(ssq * (1.f / 128.f) + EPS);
              const bf16* sg = F.SGB + (tok0 + c) * 512 + h * 128 + e0; bf16* y = F.Y + (tok0 + c) * 1024 + 512 + h * 128 + e0;
#pragma unroll
              for (int q2 = 0; q2 < 2; ++q2) { const v4u g = *(const GAS v4u*)(sg + q2 * 8); const float* gw = F.gla_w + e0 + q2 * 8; const float* oo = o + q2 * 8; v4u wv;
                  wv.x = pk2(oo[0] * rstd * gw[0] * bflo(g.x), oo[1] * rstd * gw[1] * bfhi(g.x));
                  wv.y = pk2(oo[2] * rstd * gw[2] * bflo(g.y), oo[3] * rstd * gw[3] * bfhi(g.y));
                  wv.z = pk2(oo[4] * rstd * gw[4] * bflo(g.z), oo[5] * rstd * gw[5] * bfhi(g.z));
                  wv.w = pk2(oo[6] * rstd * gw[6] * bflo(g.w), oo[7] * rstd * gw[7] * bfhi(g.w));
                  *(GAS v4u*)(y + q2 * 8) = wv; } }
            __syncthreads();
            { const int dd = tid >> 3, e0 = (tid & 7) * 16; float a[16]; const float dc = dec[dd];
#pragma unroll
              for (int i = 0; i < 16; ++i) a[i] = dc * S[dd * 128 + e0 + i];
              for (int t = 0; t < 64; ++t) { const float kv = Kst[t * 64 + dd];
#pragma unroll
                  for (int i = 0; i < 16; ++i) a[i] += kv * Vv[t * 128 + e0 + i]; }
#pragma unroll
              for (int i = 0; i < 16; ++i) S[dd * 128 + e0 + i] = a[i]; }
        }
    }
    __syncthreads();
}

__device__ __forceinline__ void final_norm(Frame& F) {
    const int gw = F.vcu * NWAVES + F.wave, NGW = F.G * NWAVES;
    f32x4 wv[4];
#pragma unroll
    for (int j = 0; j < 4; ++j) wv[j] = ((const GAS f32x4*)F.fin_w)[F.lane + 64 * j];
    for (int m = gw; m < M; m += NGW) {
        GAS f32x4* zr = (GAS f32x4*)(F.out + (size_t)m * D) + F.lane;
        f32x4 v[4]; float s = 0.f;
#pragma unroll
        for (int j = 0; j < 4; ++j) { v[j] = zr[64 * j]; s += (v[j].x * v[j].x + v[j].y * v[j].y) + (v[j].z * v[j].z + v[j].w * v[j].w); }
        const float rstd = 1.f / sqrtf(wave_sum(s) * (1.f / D) + EPS);
#pragma unroll
        for (int j = 0; j < 4; ++j) zr[64 * j] = v[j] * rstd * wv[j];
    }
}

__device__ __forceinline__ da::BlockRef attn_ref(Frame& F, int seq) {
    const int item = F.vcu + (seq >> 2) * F.G;
    const int bh = item >> 4, p = item & 15, b = bh >> 2, h = bh & 3;
    const int qb = ((seq >> 1) & 1) ? 31 - p : p, sub = seq & 1;
    const size_t row0 = (size_t)b * T + (size_t)qb * da::QB;
    da::BlockRef r;
    r.Q = F.QA + row0 * 512 + h * 128 + sub * 64;
    r.K = F.KA + (size_t)b * T * 512 + h * 128 + sub * 64;
    r.V = F.VA + (size_t)b * T * 512 + h * 128;
    r.O1 = F.O1 + row0 * 512 + h * 128; r.Y = F.Y + row0 * 1024 + h * 128; r.SG = F.SGA + row0 * 512 + h * 128;
    r.P0 = qb * da::QB; r.sub = sub; r.slope2 = exp2f(-2.f * (float)(h + 1)) * LOG2E; r.jlo = 0;
    return r;
}
__device__ __forceinline__ void fast_attn(Frame& F, char* lds) {
    da::Consts C; C.lam = lambda_full(F); C.subln_w = F.subln_w;
    da::Seam S;
    da::BlockRef cur = attn_ref(F, 0);
    da::prime(cur, lds, S);
    for (int seq = 0; seq < 8; ++seq) {
        const da::BlockRef nxt = (seq + 1 < 8) ? attn_ref(F, seq + 1) : cur;
        da::block(cur, nxt, lds, S, C);
        cur = nxt;
    }
    asm volatile("s_waitcnt vmcnt(0)" ::: "memory");
    __syncthreads();
}

struct Args { const float* in[13]; float* out; unsigned char* ws; int ph_lo, ph_hi, li, pad; };
__global__ void __launch_bounds__(NWAVES * 64, 2) hybrid_fwd(Args args) {
    extern __shared__ __attribute__((aligned(16))) unsigned char lds[];
    Frame F;
    F.lds = (LAS unsigned char*)lds;
    F.MISC = (volatile LAS unsigned*)(F.lds + MISC_OFF);
    F.tid = threadIdx.x; F.lane = F.tid & 63; F.wave = __builtin_amdgcn_readfirstlane(F.tid >> 6);
    F.G = gridDim.x; { const int bx = blockIdx.x; F.vcu = (F.G % 8 == 0) ? (bx % 8) * (F.G / 8) + bx / 8 : bx; }
    unsigned char* ws = args.ws;
    F.ctl = (gu32*)(ws + WS_CTL);
    F.x = args.in[0]; F.norm_w = args.in[1]; F.w_in = args.in[2]; F.w_gate_up = args.in[3]; F.b_gate = args.in[4];
    F.lq1 = args.in[5]; F.lk1 = args.in[6]; F.lq2 = args.in[7]; F.lk2 = args.in[8]; F.subln_w = args.in[9]; F.gla_w = args.in[10];
    F.w_out = args.in[11]; F.fin_w = args.in[12]; F.out = args.out;
    F.Win_t = (bf16*)(ws + WS_WIN); F.Wout_t = (bf16*)(ws + WS_WOUT); F.XN = (bf16*)(ws + WS_XN); F.Y = (bf16*)(ws + WS_Y);
    F.QA = (bf16*)(ws + WS_QA); F.KA = (bf16*)(ws + WS_KA); F.VA = (bf16*)(ws + WS_VA); F.SGA = (bf16*)(ws + WS_SGA);
    F.QB = (bf16*)(ws + WS_QB); F.KB = (bf16*)(ws + WS_KB); F.VB = (bf16*)(ws + WS_VB); F.SGB = (bf16*)(ws + WS_SGB);
    F.Gg = (float*)(ws + WS_G); F.O1 = (float*)(ws + WS_O1); F.GST = (float*)(ws + WS_GST);
    for (int u = F.tid; u < (LDS_BYTES - LDSCTL_OFF) / 4; u += NWAVES * 64) ((LAS unsigned*)(F.lds + LDSCTL_OFF))[u] = 0u;
    __syncthreads();
    XcdBarrier bar; bar.bar = (unsigned*)(F.ctl + CW_BAR); bar.x = 0; bar.st = nullptr;
    if (N_LAUNCHES != PER_PHASE) bar = xcd_barrier_post((unsigned*)(F.ctl + CW_BAR), F.MISC + 8);
#define GRID_BAR(seam) do { if (N_LAUNCHES == PER_PHASE) { if (F.tid == 0) __hip_atomic_store(F.ctl + CW_TMO, 0xBADBA0u | (unsigned)(seam), RLX_AGENT); } else { xcd_barrier(bar); } } while (0)
    const int lo = args.ph_lo, hi = args.ph_hi;
#define IN(k) (lo <= (k) && (k) < hi)
#define BOTH(k) (IN(k) && IN((k) + 1))
    if (IN(0)) { p0_prologue(F); if (BOTH(0)) GRID_BAR(0); }
    if (IN(1)) {
        pg8::Gemm g{F.XN, F.Win_t, M, NP, D}; pg8::StaticOrder S; S.init(M, NP, F.G, (int)blockIdx.x);
        pg8::EpiProjFast E{F.QA, F.KA, F.VA, F.SGA, F.QB, F.KB, F.VB, F.SGB, F.Gg, F.b_gate};
        pg8::gemm_phase<pg8::EpiProjFast, pg8::StaticOrder, true, true>(F.lds, g, S, E);
        if (BOTH(1)) GRID_BAR(1);
    }
    if (IN(2)) { if (BOTH(2)) GRID_BAR(2); }
    if (IN(3)) { if (F.G == 256) fast_attn(F, (char*)lds); else simple_attn(F); simple_gla(F); if (BOTH(3)) GRID_BAR(3); }
    if (IN(4)) {
        pg8::Gemm g{F.Y, F.Wout_t, M, D, D}; pg8::StaticOrder S; S.init(M, D, F.G, (int)blockIdx.x);
        pg8::EpiResFast E{F.x, F.out};
        pg8::gemm_phase<pg8::EpiResFast, pg8::StaticOrder, true, true>(F.lds, g, S, E);
        if (BOTH(4)) GRID_BAR(4);
    }
    if (IN(5)) { final_norm(F); }
#undef IN
#undef BOTH
}

extern "C" void kernel_launch(void* const* d_in, const int* in_sizes, int n_in, void* d_out, int out_size, void* d_ws, size_t ws_size, hipStream_t stream) {
    static int grid = 0;
    if (grid == 0) {
        if (n_in != 13 || in_sizes[0] != M * D || out_size != M * D || ws_size < WS_END) { fprintf(stderr, "kernel_launch: shape/workspace mismatch (n_in %d, in0 %d, out %d, ws %zu)\n", n_in, n_in > 0 ? in_sizes[0] : -1, out_size, ws_size); grid = -1; return; }
        int dev = 0, cus = 0, per_cu = 0;
        if (hipGetDevice(&dev) != hipSuccess || hipDeviceGetAttribute(&cus, hipDeviceAttributeMultiprocessorCount, dev) != hipSuccess) { grid = -1; return; }
        if (hipFuncSetAttribute((const void*)hybrid_fwd, hipFuncAttributeMaxDynamicSharedMemorySize, LDS_BYTES) != hipSuccess) { fprintf(stderr, "kernel_launch: hipFuncSetAttribute failed\n"); grid = -1; return; }
        if (hipOccupancyMaxActiveBlocksPerMultiprocessor(&per_cu, (const void*)hybrid_fwd, NWAVES * 64, LDS_BYTES) != hipSuccess || per_cu < 1) { fprintf(stderr, "kernel_launch: occupancy query says %d\n", per_cu); per_cu = 1; }
        (void)hipGetLastError();
        grid = cus;
    }
    if (grid < 0) return;
    (void)hipMemsetAsync((char*)d_ws + WS_CTL, 0, CTL_ZERO_BYTES, stream);
    Args a{};
    for (int i = 0; i < 13; ++i) a.in[i] = (const float*)d_in[i];
    a.out = (float*)d_out; a.ws = (unsigned char*)d_ws;
    if (N_LAUNCHES == 1) { a.ph_lo = 0; a.ph_hi = PER_PHASE; a.li = 0; hipLaunchKernelGGL(hybrid_fwd, dim3(grid), dim3(NWAVES * 64), LDS_BYTES, stream, a); }
    else for (int li = 0; li < PER_PHASE; ++li) { a.ph_lo = li; a.ph_hi = li + 1; a.li = li; hipLaunchKernelGGL(hybrid_fwd, dim3(grid), dim3(NWAVES * 64), LDS_BYTES, stream, a); }
}
```

```cpp
#include <hip/hip_runtime.h>
#include <cstdio>
#include <cstdint>

#ifndef MK_N_LAUNCHES
#define MK_N_LAUNCHES 1
#endif
constexpr int N_LAUNCHES = MK_N_LAUNCHES;
constexpr int PER_PHASE = 6;
constexpr int NWAVES = 8;

constexpr int BATCH = 8, T = 8192, D = 1024, M = BATCH * T;
constexpr int H = 4;
constexpr int IN_COLS = 3600;
constexpr int NP = 3840;
constexpr float EPS = 1e-6f;
constexpr float LOG2E = 1.4426950408889634f;
constexpr float C2 = 0.125f * LOG2E;
constexpr float LAM_INIT = 0.2f;

constexpr size_t MiB = 1u << 20;
constexpr size_t WS_CTL = 0, CTL_ZERO_BYTES = 1 * MiB;
constexpr size_t WS_WIN = 2 * MiB;
constexpr size_t WS_WOUT = 10 * MiB;
constexpr size_t WS_GST = 16 * MiB;
constexpr size_t WS_XN = 32 * MiB;
constexpr size_t WS_Y = 160 * MiB;
constexpr size_t WS_QA = 288 * MiB, WS_KA = 352 * MiB, WS_VA = 416 * MiB, WS_SGA = 480 * MiB;
constexpr size_t WS_QB = 544 * MiB, WS_KB = 576 * MiB;
constexpr size_t WS_VB = 608 * MiB, WS_SGB = 672 * MiB;
constexpr size_t WS_G = 736 * MiB;
constexpr size_t WS_O1 = 800 * MiB;
constexpr size_t WS_END = 928 * MiB;
constexpr int CW_TMO = 0, CW_CODE = 1, CW_BAR = 4096;

constexpr int RING_BYTES = 147456;
constexpr int LDSCTL_OFF = RING_BYTES, MISC_OFF = LDSCTL_OFF + 320;
constexpr int LDS_BYTES = RING_BYTES + 1024;

#define GAS __attribute__((address_space(1)))
#define LAS __attribute__((address_space(3)))
typedef unsigned short bf16;
typedef unsigned v4u __attribute__((ext_vector_type(4)));
typedef float f32x4 __attribute__((ext_vector_type(4)));
typedef GAS unsigned gu32;
#define RLX_AGENT __ATOMIC_RELAXED, __HIP_MEMORY_SCOPE_AGENT
#define LDS_WAIT() asm volatile("s_waitcnt lgkmcnt(0)" ::: "memory")
#define VM_WAIT() asm volatile("s_waitcnt vmcnt(0)" ::: "memory")

__device__ __forceinline__ unsigned f2bf(float f) { unsigned u = __builtin_bit_cast(unsigned, f); return (u + 0x7fffu + ((u >> 16) & 1u)) >> 16; }
__device__ __forceinline__ unsigned pk2(float lo, float hi) { return f2bf(lo) | (f2bf(hi) << 16); }
__device__ __forceinline__ float bf2f(unsigned short b) { return __builtin_bit_cast(float, (unsigned)b << 16); }
__device__ __forceinline__ float bflo(unsigned w) { return __builtin_bit_cast(float, w << 16); }
__device__ __forceinline__ float bfhi(unsigned w) { return __builtin_bit_cast(float, w & 0xffff0000u); }
__device__ __forceinline__ float silu_f(float v) { return v / (1.f + __expf(-v)); }
__device__ __forceinline__ float logsigmoid_f(float v) { return fminf(v, 0.f) - log1pf(__expf(-fabsf(v))); }

#define XB_TMO      128
#define XB_XCNT(j)  (256  + 64 * (j))
#define XB_XSUB(j)  (1280 + 64 * (j))
#define XB_XGEN(j)  (2304 + 64 * (j))
#define XB_TOP      3328
#define XB_TOPGEN   3392
#define XCD_BAR_WORDS 3456
#define XB_SPIN_CAP (1u << 22)
__device__ __forceinline__ unsigned xb_ld(unsigned* p)              { return __hip_atomic_load(p, __ATOMIC_RELAXED, __HIP_MEMORY_SCOPE_AGENT); }
__device__ __forceinline__ unsigned xb_add(unsigned* p, unsigned v) { return __hip_atomic_fetch_add(p, v, __ATOMIC_RELAXED, __HIP_MEMORY_SCOPE_AGENT); }
__device__ __forceinline__ unsigned xb_xcc_id() { return (unsigned)__builtin_amdgcn_s_getreg((3 << 11) | 20) & 0xFu; }
#define XB_SPIN(cond, bar) do { unsigned _sp = 0; while (cond) { __builtin_amdgcn_s_sleep(1); \
    if ((++_sp & 255u) == 0u) { if (xb_ld(&(bar)[XB_TMO])) break; if (_sp > XB_SPIN_CAP) { atomicAdd(&(bar)[XB_TMO], 1u); break; } } } } while (0)
struct XcdBarrier { unsigned* bar; unsigned x; volatile LAS unsigned* st; };
__device__ __forceinline__ XcdBarrier xcd_barrier_post(unsigned* bar, volatile LAS unsigned* st) {
    XcdBarrier b; b.bar = bar; b.x = xb_xcc_id(); b.st = st;
    if (threadIdx.x == 0) (void)xb_add(&bar[XB_XCNT(b.x)], 1u);
    return b;
}
__device__ __forceinline__ void xcd_barrier_complete(unsigned* bar, unsigned x, unsigned& nloc, unsigned& nx) {
    const unsigned G = gridDim.x * gridDim.y * gridDim.z;
    unsigned sum, cnt, mine, sp = 0u;
    for (;;) {
        sum = 0u; cnt = 0u; mine = 0u;
#pragma unroll
        for (unsigned j = 0; j < 16; ++j) { const unsigned c = xb_ld(&bar[XB_XCNT(j)]); sum += c; cnt += (c > 0u) ? 1u : 0u; mine = (j == x) ? c : mine; }
        if (sum == G) break;
        __builtin_amdgcn_s_sleep(1);
        if ((++sp & 255u) == 0u) { if (xb_ld(&bar[XB_TMO])) break; if (sp > XB_SPIN_CAP) { atomicAdd(&bar[XB_TMO], 1u); break; } }
    }
    nloc = mine > 0u ? mine : 1u; nx = cnt > 0u ? cnt : 1u;
}
__device__ __forceinline__ void xcd_barrier(const XcdBarrier& b) {
    asm volatile("s_waitcnt vmcnt(0)" ::: "memory");
    __syncthreads();
    if (threadIdx.x == 0) {
        unsigned* bar = b.bar;
        __builtin_amdgcn_s_waitcnt(0);
        unsigned nloc = b.st[0], nx = b.st[1];
        if (nloc == 0u) { xcd_barrier_complete(bar, b.x, nloc, nx); b.st[0] = nloc; b.st[1] = nx; }
        const unsigned old = xb_add(&bar[XB_XSUB(b.x)], 1u);
        const unsigned gen = old / nloc;
        if (old + 1u == (gen + 1u) * nloc) {
            __builtin_amdgcn_fence(__ATOMIC_RELEASE, "agent");
            asm volatile("s_waitcnt vmcnt(0)" ::: "memory");
            const unsigned og = xb_add(&bar[XB_TOP], 1u);
            const unsigned tg = og / nx;
            if (og + 1u == (tg + 1u) * nx) xb_add(&bar[XB_TOPGEN], 1u);
            else XB_SPIN(xb_ld(&bar[XB_TOPGEN]) == tg, bar);
            __builtin_amdgcn_fence(__ATOMIC_ACQUIRE, "agent");
            xb_add(&bar[XB_XGEN(b.x)], 1u);
            asm volatile("s_waitcnt vmcnt(0)" ::: "memory");
        } else {
            XB_SPIN(xb_ld(&bar[XB_XGEN(b.x)]) == gen, bar);
            __builtin_amdgcn_fence(__ATOMIC_ACQUIRE, "agent");
            asm volatile("s_waitcnt vmcnt(0)" ::: "memory");
        }
    }
    __syncthreads();
}

namespace pg8 {
#define PG8_LAS __attribute__((address_space(3)))
typedef unsigned short bf16_t;
typedef short bf16x8 __attribute__((ext_vector_type(8)));
typedef float f32x4 __attribute__((ext_vector_type(4)));
typedef unsigned u32x4 __attribute__((ext_vector_type(4)));
constexpr int BM = 256, BK = 64, HALF = 128, HTB = HALF * BK * 2  , STAGE_BYTES = 8 * HTB, NXCD = 8, WGM = 8;

__host__ __device__ __forceinline__ int lds_byte(int r, int c) { const int st = (r >> 4) * 2 + (c >> 5), rr = r & 15, cc = c & 31, ob = rr * 64 + cc * 2; return st * 1024 + (ob ^ (((ob >> 9) & 1) << 5)); }
__host__ __device__ __forceinline__ void stage_rc(int b, int& R, int& C) { const int st = b / 1024, sb = b % 1024, swz = sb ^ (((sb >> 9) & 1) << 5); R = (st >> 1) * 16 + swz / 64; C = (st & 1) * 32 + (swz % 64) / 2; }
__host__ __device__ __forceinline__ int perm32(int rho) { const int n = rho >> 4, i = rho & 15; return 8 * (i >> 2) + 4 * n + (i & 3); }

struct Unit { int pm, pn; };
struct Gemm { const bf16_t* A; const bf16_t* Bt; int M, N, K; };

struct StaticOrder {
    int nM, nN, nwg, G, c;
    __host__ __device__ void init(int M, int N, int G_, int c_) { nM = M / BM; nN = N / BM; nwg = nM * nN; G = G_; c = c_; }
    __host__ __device__ bool next(int i, Unit& u) const {
        const long L = (long)i * G + c; if (L >= nwg) return false;
        int wgid = (int)L; { const int q = nwg / NXCD, r = nwg % NXCD, xcd = wgid % NXCD, off = wgid / NXCD; wgid = (xcd < r ? xcd * (q + 1) : r * (q + 1) + (xcd - r) * q) + off; }
        const int nig = WGM * nN, gid = wgid / nig, fm = gid * WGM, gsz = (nM - fm) < WGM ? (nM - fm) : WGM;
        u.pm = fm + ((wgid % nig) % gsz); u.pn = (wgid % nig) / gsz; return true;
    }
    __device__ __forceinline__ void a_ready(const Unit&) const {}
    __device__ __forceinline__ void done(const Unit&) const {}
};


__device__ __forceinline__ unsigned cvt_pk_bf16(float lo, float hi) { unsigned r; asm volatile("v_cvt_pk_bf16_f32 %0, %1, %2" : "=v"(r) : "v"(lo), "v"(hi)); return r; }

struct EpiProjFast {
    static constexpr bool PERM = true, AFTER_DRAIN = false;
    bf16_t *QA, *KA, *VA, *SGA, *QB, *KB, *VB, *SGB; float* Gg; const float* b_gate;
    __device__ __forceinline__ void operator()(const f32x4 (&acc)[2][2][4][2], const Unit& u, int wr, int wc, int fr, int fq) const {
        const int pn = u.pn, row0 = u.pm * BM + wr * 64 + fr, col0 = wc * 32 + 8 * fq;
        if (pn == 14) {
            f32x4 bv[2][2];
#pragma unroll
            for (int bj = 0; bj < 2; ++bj)
#pragma unroll
                for (int n = 0; n < 2; ++n) bv[bj][n] = *(const f32x4*)(b_gate + col0 + bj * HALF + 4 * n);
#pragma unroll
            for (int ai = 0; ai < 2; ++ai)
#pragma unroll
                for (int m = 0; m < 4; ++m) { float* rowp = Gg + (size_t)(row0 + ai * HALF + m * 16) * 256 + col0;
#pragma unroll
                    for (int bj = 0; bj < 2; ++bj)
#pragma unroll
                        for (int n = 0; n < 2; ++n) { f32x4 v = acc[ai][bj][m][n] + bv[bj][n];
#pragma unroll
                            for (int e = 0; e < 4; ++e) v[e] = logsigmoid_f(v[e]) * (1.f / 16.f);
                            *(f32x4*)(rowp + bj * HALF + 4 * n) = v; } }
            return;
        }
        bf16_t* base; int ldc = 512, cofs; float sc = 1.f; bool act = false;
        if (pn < 2) { base = QA; cofs = pn * 256; sc = C2; }
        else if (pn < 4) { base = KA; cofs = (pn - 2) * 256; }
        else if (pn < 6) { base = VA; cofs = (pn - 4) * 256; }
        else if (pn < 8) { base = SGA; cofs = (pn - 6) * 256; act = true; }
        else if (pn == 8) { base = QB; ldc = 256; cofs = 0; sc = 0.125f; }
        else if (pn == 9) { base = KB; ldc = 256; cofs = 0; }
        else if (pn < 12) { base = VB; cofs = (pn - 10) * 256; }
        else { base = SGB; cofs = (pn - 12) * 256; act = true; }
#pragma unroll
        for (int ai = 0; ai < 2; ++ai)
#pragma unroll
            for (int m = 0; m < 4; ++m) { bf16_t* rowp = base + (size_t)(row0 + ai * HALF + m * 16) * ldc + cofs + col0;
#pragma unroll
                for (int bj = 0; bj < 2; ++bj) { f32x4 v0 = acc[ai][bj][m][0], v1 = acc[ai][bj][m][1];
                    if (act) {
#pragma unroll
                        for (int e = 0; e < 4; ++e) { v0[e] = v0[e] * __builtin_amdgcn_rcpf(1.f + __expf(-v0[e])); v1[e] = v1[e] * __builtin_amdgcn_rcpf(1.f + __expf(-v1[e])); }
                    } else { v0 = v0 * sc; v1 = v1 * sc; }
                    u32x4 w; w.x = cvt_pk_bf16(v0[0], v0[1]); w.y = cvt_pk_bf16(v0[2], v0[3]); w.z = cvt_pk_bf16(v1[0], v1[1]); w.w = cvt_pk_bf16(v1[2], v1[3]);
                    *(u32x4*)(rowp + bj * HALF) = w; } }
    }
};
struct EpiResFast {
    static constexpr bool PERM = false, AFTER_DRAIN = false;
    const float* x; float* out;
    __device__ __forceinline__ void operator()(const f32x4 (&acc)[2][2][4][2], const Unit& u, int wr, int wc, int fr, int fq) const {
        const int row0 = u.pm * BM + wr * 64 + fr, col0 = u.pn * BM + wc * 32 + 4 * fq;
#pragma unroll
        for (int ai = 0; ai < 2; ++ai)
#pragma unroll
            for (int m = 0; m < 4; ++m) { const size_t off = (size_t)(row0 + ai * HALF + m * 16) * 1024 + col0;
#pragma unroll
                for (int bj = 0; bj < 2; ++bj)
#pragma unroll
                    for (int n = 0; n < 2; ++n) { const size_t i = off + bj * HALF + n * 16; *(f32x4*)(out + i) = *(const f32x4*)(x + i) + acc[ai][bj][m][n]; } }
    }
};
template <class Epi, class Sched, bool ALIGN_EPI = false, bool SP2 = false>
__device__ __forceinline__ void gemm_phase(PG8_LAS unsigned char* lds, const Gemm g, const Sched& S, const Epi& E) {
    const int tid = threadIdx.x, wid = __builtin_amdgcn_readfirstlane(tid >> 6), lane = tid & 63, wr = wid >> 2, wc = wid & 3, fr = lane & 15, fq = lane >> 4;
    const int K = g.K, nt = K / BK;
    unsigned voffA[2], voffB[2];
#pragma unroll
    for (int i = 0; i < 2; ++i) { int R, C; stage_rc(tid * 16 + i * 8192, R, C); const int Rb = Epi::PERM ? ((R & ~31) + perm32(R & 31)) : R;
        voffA[i] = (unsigned)(R * K + C) * 2u; voffB[i] = (unsigned)(Rb * K + C) * 2u; }
    const size_t kstep = (size_t)(BK * 2);
    const size_t hstep = (size_t)HALF * K * 2;
    const size_t tstep = 2 * hstep;
    const unsigned ldsw = (unsigned)wid * 1024u;
    const int aoff = lds_byte(wr * 64 + fr, fq * 8), boff = lds_byte(wc * 32 + fr, fq * 8);
#define PG8_SA(b, h) (((b) * 2 + (h)) * HTB)
#define PG8_SB(b, h) ((4 + (b) * 2 + (h)) * HTB)
#define PG8_STAGE(bufoff, gbase, voff) do { _Pragma("unroll") for (int _i = 0; _i < 2; ++_i) \
        __builtin_amdgcn_global_load_lds((const unsigned*)((const char*)(gbase) + (voff)[_i]), (PG8_LAS unsigned*)(lds + (bufoff) + ldsw + _i * 8192), 16, 0, 0); } while (0)
#define PG8_LDA(dst, b, h) do { _Pragma("unroll") for (int m = 0; m < 4; ++m) _Pragma("unroll") for (int k = 0; k < 2; ++k) dst[m][k] = *(const PG8_LAS bf16x8*)(lds + PG8_SA(b, h) + aoff + m * 2048 + k * 1024); } while (0)
#define PG8_LDB(dst, b, h) do { _Pragma("unroll") for (int n = 0; n < 2; ++n) _Pragma("unroll") for (int k = 0; k < 2; ++k) dst[n][k] = *(const PG8_LAS bf16x8*)(lds + PG8_SB(b, h) + boff + n * 2048 + k * 1024); } while (0)
#define PG8_MMA(ai, bj, At, Bt) do { __builtin_amdgcn_s_setprio(1); _Pragma("unroll") for (int m = 0; m < 4; ++m) _Pragma("unroll") for (int n = 0; n < 2; ++n) _Pragma("unroll") for (int k = 0; k < 2; ++k) \
        acc[ai][bj][m][n] = __builtin_amdgcn_mfma_f32_16x16x32_bf16(Bt[n][k], At[m][k], acc[ai][bj][m][n], 0, 0, 0); __builtin_amdgcn_s_setprio(0); } while (0)
#define PG8_WAIT_V(n) asm volatile("s_waitcnt vmcnt(" #n ")" ::: "memory")
#define PG8_WAIT_L(n) asm volatile("s_waitcnt lgkmcnt(" #n ")" ::: "memory")
#define PG8_BAR __builtin_amdgcn_s_barrier()
#define PG8_SCHED __builtin_amdgcn_sched_barrier(0)
    Unit cur, nxt; int ui = 0;
    if (!S.next(0, cur)) return;
    f32x4 acc[2][2][4][2];
#pragma unroll
    for (int a = 0; a < 2; ++a)
#pragma unroll
        for (int b = 0; b < 2; ++b)
#pragma unroll
            for (int m = 0; m < 4; ++m)
#pragma unroll
                for (int n = 0; n < 2; ++n) acc[a][b][m][n] = (f32x4){0.f, 0.f, 0.f, 0.f};
    bf16x8 At[4][2], B0[2][2], B1[2][2];
    const char* cA = (const char*)g.A + (size_t)cur.pm * tstep; const char* cB = (const char*)g.Bt + (size_t)cur.pn * tstep;
    S.a_ready(cur);
    if constexpr (SP2) {
        PG8_STAGE(PG8_SB(0, 0), cB, voffB); PG8_STAGE(PG8_SB(0, 1), cB + hstep, voffB); PG8_STAGE(PG8_SA(0, 0), cA, voffA); PG8_STAGE(PG8_SA(0, 1), cA + hstep, voffA);
        if (wr == 1) PG8_BAR;
        PG8_WAIT_V(2); PG8_BAR;
        PG8_STAGE(PG8_SB(1, 0), cB + kstep, voffB); PG8_STAGE(PG8_SA(1, 0), cA + kstep, voffA); PG8_STAGE(PG8_SB(1, 1), cB + hstep + kstep, voffB);
        PG8_WAIT_V(6); PG8_BAR;
    } else {
        PG8_STAGE(PG8_SB(0, 0), cB, voffB); PG8_STAGE(PG8_SA(0, 0), cA, voffA); PG8_STAGE(PG8_SB(0, 1), cB + hstep, voffB); PG8_STAGE(PG8_SA(0, 1), cA + hstep, voffA);
        if (wr == 1) PG8_BAR;
        PG8_WAIT_V(4); PG8_BAR;
        PG8_STAGE(PG8_SB(1, 0), cB + kstep, voffB); PG8_STAGE(PG8_SA(1, 0), cA + kstep, voffA); PG8_STAGE(PG8_SB(1, 1), cB + hstep + kstep, voffB);
        PG8_WAIT_V(6); PG8_BAR;
    }
    for (;;) {
        const bool has_next = S.next(ui + 1, nxt);
        const char* nA = has_next ? (const char*)g.A + (size_t)nxt.pm * tstep : cA; const char* nB = has_next ? (const char*)g.Bt + (size_t)nxt.pn * tstep : cB;
        for (int t = 0; t < nt; t += 2) {
            const bool last = (t == nt - 2);
            const char* a1 = cA + (size_t)(t + 1) * kstep;
            const char* a2 = last ? nA : cA + (size_t)(t + 2) * kstep; const char* b2 = last ? nB : cB + (size_t)(t + 2) * kstep;
            const char* a3 = a2 + kstep; const char* b3 = b2 + kstep;
            if (last && has_next) S.a_ready(nxt);
            if constexpr (SP2) {
            PG8_LDB(B0, 0, 0); PG8_LDB(B1, 0, 1); PG8_SCHED; PG8_LDA(At, 0, 0); PG8_STAGE(PG8_SA(1, 1), a1 + hstep, voffA);
            PG8_WAIT_V(8); PG8_WAIT_L(0); PG8_BAR; PG8_MMA(0, 0, At, B0); PG8_MMA(0, 1, At, B1); PG8_BAR; PG8_SCHED;
            PG8_LDA(At, 0, 1); PG8_STAGE(PG8_SB(0, 0), b2, voffB); PG8_STAGE(PG8_SB(0, 1), b2 + hstep, voffB); PG8_STAGE(PG8_SA(0, 0), a2, voffA);
            PG8_WAIT_V(8); PG8_WAIT_L(0); PG8_BAR; PG8_MMA(1, 0, At, B0); PG8_MMA(1, 1, At, B1); PG8_BAR; PG8_SCHED;
            PG8_LDB(B0, 1, 0); PG8_LDB(B1, 1, 1); PG8_SCHED; PG8_LDA(At, 1, 0); PG8_STAGE(PG8_SA(0, 1), a2 + hstep, voffA);
            PG8_WAIT_V(8); PG8_WAIT_L(0); PG8_BAR; PG8_MMA(0, 0, At, B0); PG8_MMA(0, 1, At, B1); PG8_BAR; PG8_SCHED;
            PG8_LDA(At, 1, 1); PG8_STAGE(PG8_SB(1, 0), b3, voffB); PG8_STAGE(PG8_SB(1, 1), b3 + hstep, voffB); PG8_STAGE(PG8_SA(1, 0), a3, voffA);
            PG8_WAIT_V(8); PG8_WAIT_L(0); PG8_BAR; PG8_MMA(1, 0, At, B0); PG8_MMA(1, 1, At, B1); PG8_BAR; PG8_SCHED;
            } else {
            PG8_LDB(B0, 0, 0); PG8_SCHED; PG8_LDA(At, 0, 0); PG8_STAGE(PG8_SA(1, 1), a1 + hstep, voffA);
            PG8_WAIT_L(8); PG8_BAR; PG8_WAIT_L(0); PG8_MMA(0, 0, At, B0); PG8_BAR; PG8_SCHED;
            PG8_LDB(B1, 0, 1); PG8_STAGE(PG8_SB(0, 0), b2, voffB);
            PG8_BAR; PG8_WAIT_L(0); PG8_MMA(0, 1, At, B1); PG8_BAR;
            PG8_LDA(At, 0, 1); PG8_STAGE(PG8_SA(0, 0), a2, voffA);
            PG8_BAR; PG8_WAIT_L(0); PG8_MMA(1, 0, At, B0); PG8_BAR; PG8_SCHED;
            PG8_STAGE(PG8_SB(0, 1), b2 + hstep, voffB);
            PG8_WAIT_V(6); PG8_BAR; PG8_MMA(1, 1, At, B1); PG8_BAR;
            PG8_LDB(B0, 1, 0); PG8_SCHED; PG8_LDA(At, 1, 0); PG8_STAGE(PG8_SA(0, 1), a2 + hstep, voffA);
            PG8_WAIT_L(8); PG8_BAR; PG8_WAIT_L(0); PG8_MMA(0, 0, At, B0); PG8_BAR; PG8_SCHED;
            PG8_LDB(B1, 1, 1); PG8_STAGE(PG8_SB(1, 0), b3, voffB);
            PG8_BAR; PG8_WAIT_L(0); PG8_MMA(0, 1, At, B1); PG8_BAR;
            PG8_LDA(At, 1, 1); PG8_STAGE(PG8_SA(1, 0), a3, voffA);
            PG8_BAR; PG8_WAIT_L(0); PG8_MMA(1, 0, At, B0); PG8_BAR; PG8_SCHED;
            PG8_STAGE(PG8_SB(1, 1), b3 + hstep, voffB);
            PG8_WAIT_V(6); PG8_BAR; PG8_MMA(1, 1, At, B1); PG8_BAR;
            }
        }
        if constexpr (ALIGN_EPI) { if (wr == 0) PG8_BAR; }
        if constexpr (!Epi::AFTER_DRAIN) { E(acc, cur, wr, wc, fr, fq); S.done(cur); }
        if (!has_next) break;
#pragma unroll
        for (int a = 0; a < 2; ++a)
#pragma unroll
            for (int b = 0; b < 2; ++b)
#pragma unroll
                for (int m = 0; m < 4; ++m)
#pragma unroll
                    for (int n = 0; n < 2; ++n) acc[a][b][m][n] = (f32x4){0.f, 0.f, 0.f, 0.f};
        cur = nxt; cA = nA; cB = nB; ++ui;
        if constexpr (ALIGN_EPI) { if (wr == 1) PG8_BAR; }
    }
    PG8_WAIT_V(0);
    if constexpr (!ALIGN_EPI) { if (wr == 0) PG8_BAR; }
    PG8_BAR;
    if constexpr (Epi::AFTER_DRAIN) { E.fused(acc, cur, wr, wc, fr, fq, lds, wid, lane); S.done(cur); }
#undef PG8_SA
#undef PG8_SB
#undef PG8_STAGE
#undef PG8_LDA
#undef PG8_LDB
#undef PG8_MMA
#undef PG8_WAIT_V
#undef PG8_WAIT_L
#undef PG8_BAR
#undef PG8_SCHED
}
}

struct Frame {
    LAS unsigned char* lds;
    volatile LAS unsigned* MISC;
    gu32* ctl;
    int tid, lane, wave, vcu, G;
    const float *x, *norm_w, *w_in, *w_gate_up, *b_gate, *lq1, *lk1, *lq2, *lk2, *subln_w, *gla_w, *w_out, *fin_w;
    float* out;
    bf16 *Win_t, *Wout_t, *XN, *Y, *QA, *KA, *VA, *SGA, *QB, *KB, *VB, *SGB;
    float *Gg, *O1, *GST;
};
__device__ __forceinline__ float wave_sum(float v) {
#pragma unroll
    for (int o = 1; o < 64; o <<= 1) v += __shfl_xor(v, o);
    return v;
}

__device__ __forceinline__ void p0_transpose_item(const float* W, int K, int ldw, int nblk, const float* ks, bf16* WT, int row_off, LAS float* scr, int item, int lane) {
    const int kb = item / nblk, nb = item % nblk, k0 = 64 * kb, n0 = 32 * nb;
#pragma unroll 8
    for (int i = 0; i < 32; ++i) { const int kk = 2 * i + (lane >> 5); float v = W[(size_t)(k0 + kk) * ldw + n0 + (lane & 31)]; if (ks) v *= ks[k0 + kk]; scr[kk * 33 + (lane & 31)] = v; }
    LDS_WAIT(); asm volatile("" ::: "memory");
    const int c = lane & 7;
#pragma unroll
    for (int j = 0; j < 4; ++j) { const int n = (lane >> 3) + 8 * j; const LAS float* s = scr + (8 * c) * 33 + n;
        v4u o; o.x = pk2(s[0 * 33], s[1 * 33]); o.y = pk2(s[2 * 33], s[3 * 33]); o.z = pk2(s[4 * 33], s[5 * 33]); o.w = pk2(s[6 * 33], s[7 * 33]);
        *(GAS v4u*)(WT + (size_t)(row_off + n0 + n) * K + k0 + 8 * c) = o; }
    LDS_WAIT(); asm volatile("" ::: "memory");
}
__device__ __forceinline__ void rms_row_to_bf16(Frame& F, const float* xrow, bf16* orow) {
    const GAS f32x4* xr = (const GAS f32x4*)xrow + F.lane;
    f32x4 v[4]; float s = 0.f;
#pragma unroll
    for (int j = 0; j < 4; ++j) { v[j] = xr[64 * j]; s += (v[j].x * v[j].x + v[j].y * v[j].y) + (v[j].z * v[j].z + v[j].w * v[j].w); }
    const float rstd = 1.f / sqrtf(wave_sum(s) * (1.f / D) + EPS);
    GAS unsigned long long* o8 = (GAS unsigned long long*)orow + F.lane;
#pragma unroll
    for (int j = 0; j < 4; ++j) o8[64 * j] = (unsigned long long)pk2(v[j].x * rstd, v[j].y * rstd) | ((unsigned long long)pk2(v[j].z * rstd, v[j].w * rstd) << 32);
}
__device__ __forceinline__ void p0_prologue(Frame& F) {
    LAS float* scr = (LAS float*)(F.lds + F.wave * 16384);
    const int gw = F.vcu * NWAVES + F.wave, NGW = F.G * NWAVES;
    constexpr int I_IN = (D / 64) * (3584 / 32), I_OUT = (D / 64) * (D / 32);
    for (int it = gw; it < I_IN + I_OUT; it += NGW) {
        if (it < I_IN) p0_transpose_item(F.w_in, D, IN_COLS, 3584 / 32, F.norm_w, F.Win_t, 0, scr, it, F.lane);
        else p0_transpose_item(F.w_out, D, D, D / 32, nullptr, F.Wout_t, 0, scr, it - I_IN, F.lane);
    }
    const int gt = (F.vcu * NWAVES + F.wave) * 64 + F.lane, NGT = NGW * 64;
    for (int it = gt; it < 256 * (D / 8); it += NGT) {
        const int j = it / (D / 8), k0 = (it % (D / 8)) * 8;
        float wg[16];
#pragma unroll
        for (int r = 0; r < 16; ++r) wg[r] = F.w_gate_up[r * 256 + j];
        float o[8];
#pragma unroll
        for (int i = 0; i < 8; ++i) { const float* wr = F.w_in + (size_t)(k0 + i) * IN_COLS + 3584; float a = 0.f;
#pragma unroll
            for (int r = 0; r < 16; ++r) a += wr[r] * wg[r];
            o[i] = a * F.norm_w[k0 + i]; }
        v4u w; w.x = pk2(o[0], o[1]); w.y = pk2(o[2], o[3]); w.z = pk2(o[4], o[5]); w.w = pk2(o[6], o[7]);
        *(GAS v4u*)(F.Win_t + (size_t)(3584 + j) * D + k0) = w;
    }
    for (int m = gw; m < M; m += NGW) rms_row_to_bf16(F, F.x + (size_t)m * D, F.XN + (size_t)m * D);
}

__device__ __forceinline__ float lambda_full(Frame& F) {
    float s1 = 0.f, s2 = 0.f;
    for (int i = 0; i < 64; ++i) { s1 += F.lq1[i] * F.lk1[i]; s2 += F.lq2[i] * F.lk2[i]; }
    return __expf(s1) - __expf(s2) + LAM_INIT;
}
__device__ __forceinline__ void simple_attn(Frame& F) {
    LAS float* Ks = (LAS float*)F.lds;
    LAS float* Vs = Ks + 64 * 64;
    const int tid = F.tid;
    const float lam = lambda_full(F);
    for (int u = blockIdx.x; u < 256; u += gridDim.x) {
        const int b = u >> 5, h = (u >> 3) & 3, p = u & 7;
        const float slope2 = exp2f(-2.f * (float)(h + 1)) * LOG2E;
        for (int half = 0; half < 2; ++half) {
            const int rb = half ? 15 - p : p;
            const int row = rb * 512 + tid;
            const size_t grow = (size_t)b * T + row;
            const int ntiles = (rb * 512 + 512) / 64;
            float ssq = 0.f;
            float* o1 = F.O1 + grow * 512 + h * 128;
            for (int pass = 0; pass < 4; ++pass) {
                const int sub = pass >> 1, eh = pass & 1;
                unsigned qw[32];
                { const GAS v4u* qp = (const GAS v4u*)(F.QA + grow * 512 + h * 128 + sub * 64);
#pragma unroll
                  for (int i = 0; i < 8; ++i) { const v4u w = qp[i]; qw[4 * i] = w.x; qw[4 * i + 1] = w.y; qw[4 * i + 2] = w.z; qw[4 * i + 3] = w.w; } }
                float mx = -1e30f, l = 0.f; float o[64];
#pragma unroll
                for (int e = 0; e < 64; ++e) o[e] = 0.f;
                for (int kt = 0; kt < ntiles; ++kt) {
                    __syncthreads();
                    { const int key = tid >> 3, seg = (tid & 7) * 8; const size_t kr = (size_t)b * T + kt * 64 + key;
                      const v4u w = *(const GAS v4u*)(F.KA + kr * 512 + h * 128 + sub * 64 + seg);
                      LAS float* d = Ks + key * 64 + seg; d[0] = bflo(w.x); d[1] = bfhi(w.x); d[2] = bflo(w.y); d[3] = bfhi(w.y); d[4] = bflo(w.z); d[5] = bfhi(w.z); d[6] = bflo(w.w); d[7] = bfhi(w.w);
                      const v4u x = *(const GAS v4u*)(F.VA + kr * 512 + h * 128 + eh * 64 + seg);
                      LAS float* e = Vs + key * 64 + seg; e[0] = bflo(x.x); e[1] = bfhi(x.x); e[2] = bflo(x.y); e[3] = bfhi(x.y); e[4] = bflo(x.z); e[5] = bfhi(x.z); e[6] = bflo(x.w); e[7] = bfhi(x.w); }
                    __syncthreads();
                    const int jn = row - kt * 64;
                    for (int j = 0; j < 64; ++j) {
                        if (j > jn) break;
                        float s = 0.f;
#pragma unroll
                        for (int dd = 0; dd < 32; ++dd) { s += bflo(qw[dd]) * Ks[j * 64 + 2 * dd]; s += bfhi(qw[dd]) * Ks[j * 64 + 2 * dd + 1]; }
                        s -= slope2 * (float)(jn - j);
                        if (s > mx) { const float al = exp2f(mx - s); l *= al;
#pragma unroll
                            for (int e = 0; e < 64; ++e) o[e] *= al;
                            mx = s; }
                        const float pp = exp2f(s - mx); l += pp;
#pragma unroll
                        for (int e = 0; e < 64; ++e) o[e] += pp * Vs[j * 64 + e];
                    }
                }
                const float rl = 1.f / l;
                if (sub == 0) {
#pragma unroll
                    for (int e = 0; e < 64; e += 4) *(GAS f32x4*)(o1 + eh * 64 + e) = (f32x4){o[e] * rl, o[e + 1] * rl, o[e + 2] * rl, o[e + 3] * rl};
                } else {
#pragma unroll
                    for (int e = 0; e < 64; e += 4) { const f32x4 a = *(const GAS f32x4*)(o1 + eh * 64 + e);
                        const f32x4 dv = (f32x4){a.x - lam * o[e] * rl, a.y - lam * o[e + 1] * rl, a.z - lam * o[e + 2] * rl, a.w - lam * o[e + 3] * rl};
                        ssq += (dv.x * dv.x + dv.y * dv.y) + (dv.z * dv.z + dv.w * dv.w);
                        *(GAS f32x4*)(o1 + eh * 64 + e) = dv; }
                }
            }
            {
                const float rstd = (1.f - LAM_INIT) / sqrtf(ssq * (1.f / 128.f) + EPS);
                const bf16* sg = F.SGA + grow * 512 + h * 128; bf16* y = F.Y + grow * 1024 + h * 128;
                for (int e = 0; e < 128; e += 8) { const v4u g = *(const GAS v4u*)(sg + e); const f32x4 a0 = *(const GAS f32x4*)(o1 + e), a1 = *(const GAS f32x4*)(o1 + e + 4); v4u w;
                    w.x = pk2(a0.x * rstd * F.subln_w[e] * bflo(g.x), a0.y * rstd * F.subln_w[e + 1] * bfhi(g.x));
                    w.y = pk2(a0.z * rstd * F.subln_w[e + 2] * bflo(g.y), a0.w * rstd * F.subln_w[e + 3] * bfhi(g.y));
                    w.z = pk2(a1.x * rstd * F.subln_w[e + 4] * bflo(g.z), a1.y * rstd * F.subln_w[e + 5] * bfhi(g.z));
                    w.w = pk2(a1.z * rstd * F.subln_w[e + 6] * bflo(g.w), a1.w * rstd * F.subln_w[e + 7] * bfhi(g.w));
                    *(GAS v4u*)(y + e) = w; }
            }
        }
    }
    __syncthreads();
}

namespace da {
typedef short bf16x8 __attribute__((ext_vector_type(8)));
typedef short s16x4 __attribute__((ext_vector_type(4)));
typedef float f32x16 __attribute__((ext_vector_type(16)));
typedef unsigned u32x4 __attribute__((ext_vector_type(4)));
constexpr int NW = 8, QBLK = 32, KVBLK = 64, QB = NW * QBLK;
constexpr int SHM_V = KVBLK * 128 * 2, SHM_K = KVBLK * 64 * 2;
constexpr int ATT_LDS = 2 * SHM_V + 2 * SHM_K + NW * 64 * 4;
constexpr int PQ = 512, PK = 512, PV = 512;
constexpr float THR2 = 8.f;
#define DA_KSWZ(row, colB) ((row) * 128 + ((colB) ^ ((((row) >> 1) & 7) << 4)))
#define DA_SBAR() __builtin_amdgcn_sched_barrier(0)
__device__ __forceinline__ int v_st(int k, int c) { const int kk = (k & ~0xC) | ((k & 4) << 1) | ((k & 8) >> 1); return ((kk >> 3) * 4 + (c >> 5)) * 512 + ((kk & 7) * 32 + (c & 31)) * 2; }
__device__ __forceinline__ int v_rd_base(int lane) { return ((lane & 3) << 3) | (((lane >> 2) & 3) << 6) | (((lane >> 4) & 1) << 5) | (((lane >> 5) & 1) << 8); }
constexpr int v_rd_off(int d0, int ks, int half) { return d0 * 512 + ks * 4096 + half * 2048; }
__device__ __forceinline__ int crow(int r, int hi) { return (r & 3) + 8 * (r >> 2) + 4 * hi; }
__device__ __forceinline__ unsigned cvtpk(float lo, float hi) { unsigned r; asm volatile("v_cvt_pk_bf16_f32 %0, %1, %2" : "=v"(r) : "v"(lo), "v"(hi)); return r; }
__device__ __forceinline__ void mask_tile(f32x16& p0, f32x16& p1, int dq) {
    const float NEG = -__builtin_inff();
#pragma unroll
    for (int r = 0; r < 16; ++r) { const int c = (r & 3) + 8 * (r >> 2); if (c > dq) p0[r] = NEG; if (c + 32 > dq) p1[r] = NEG; }
}
__device__ __forceinline__ void partialSM(f32x16& p0, f32x16& p1, float& m_reg, float& alpha) {
    float pmax = p0[0];
#pragma unroll
    for (int r = 1; r < 16; ++r) pmax = fmaxf(pmax, p0[r]);
#pragma unroll
    for (int r = 0; r < 16; ++r) pmax = fmaxf(pmax, p1[r]);
    { auto rr = __builtin_amdgcn_permlane32_swap(__float_as_uint(pmax), __float_as_uint(pmax), false, false);
      pmax = fmaxf(__uint_as_float(rr[0]), __uint_as_float(rr[1])); }
    float mn;
    if (__builtin_expect(__all(pmax - m_reg <= THR2), 1)) { mn = m_reg; alpha = 1.f; }
    else { mn = fmaxf(m_reg, pmax); alpha = __builtin_amdgcn_exp2f(m_reg - mn); m_reg = mn; }
#pragma unroll
    for (int r = 0; r < 16; ++r) { p0[r] -= mn; p1[r] -= mn; }
#pragma unroll
    for (int r = 0; r < 16; ++r) p0[r] = __builtin_amdgcn_exp2f(p0[r]);
}
__device__ __forceinline__ void finishSM(f32x16& p0, f32x16& p1, float alpha, float& l_reg, bf16x8& pa0, bf16x8& pa1, bf16x8& pa2, bf16x8& pa3) {
#pragma unroll
    for (int r = 0; r < 16; ++r) p1[r] = __builtin_amdgcn_exp2f(p1[r]);
    float ps = 0;
#pragma unroll
    for (int r = 0; r < 16; ++r) ps += p0[r];
#pragma unroll
    for (int r = 0; r < 16; ++r) ps += p1[r];
    { auto rr = __builtin_amdgcn_permlane32_swap(__float_as_uint(ps), __float_as_uint(ps), false, false);
      ps = __uint_as_float(rr[0]) + __uint_as_float(rr[1]); }
    l_reg = l_reg * alpha + ps;
#define DA_PK4(P, B_, OUT) do { unsigned a0 = cvtpk(P[B_+0], P[B_+1]), a1 = cvtpk(P[B_+2], P[B_+3]);                          \
        unsigned b0 = cvtpk(P[B_+4], P[B_+5]), b1 = cvtpk(P[B_+6], P[B_+7]);                                             \
        auto r0 = __builtin_amdgcn_permlane32_swap(a0, b0, false, false); auto r1 = __builtin_amdgcn_permlane32_swap(a1, b1, false, false); \
        u32x4 w = {r0[0], r1[0], r0[1], r1[1]}; OUT = *reinterpret_cast<bf16x8*>(&w); } while (0)
    DA_PK4(p0, 0, pa0); DA_PK4(p0, 8, pa1); DA_PK4(p1, 0, pa2); DA_PK4(p1, 8, pa3);
#undef DA_PK4
}
template <int KB>
__device__ __forceinline__ void qkt(f32x16& p0, f32x16& p1, const char* K_lds, int r32, int hi, const bf16x8* qr, float bias0, float slope2) {
#pragma unroll
    for (int r = 0; r < 16; ++r) { const float c = (float)((r & 3) + 8 * (r >> 2)); p0[r] = fmaf(slope2, c, bias0); p1[r] = fmaf(slope2, c + 32.f, bias0); }
    const char* kb[4];
#pragma unroll
    for (int dd = 0; dd < 4; ++dd) kb[dd] = K_lds + KB * SHM_K + DA_KSWZ(r32, (dd * 16 + hi * 8) * 2);
#pragma unroll
    for (int d0 = 0; d0 < 4; ++d0) {
        bf16x8 b0 = *reinterpret_cast<const bf16x8*>(kb[d0]);
        bf16x8 b1 = *reinterpret_cast<const bf16x8*>(kb[d0] + 32 * 128);
        p0 = __builtin_amdgcn_mfma_f32_32x32x16_bf16(b0, qr[d0], p0, 0, 0, 0);
        p1 = __builtin_amdgcn_mfma_f32_32x32x16_bf16(b1, qr[d0], p1, 0, 0, 0); }
}
template <int VB>
__device__ __forceinline__ void pv_tile(f32x16* o, int vb0, bf16x8 pa0, bf16x8 pa1, bf16x8 pa2, bf16x8 pa3) {
#define DA_TRRD(dst, off) asm volatile("ds_read_b64_tr_b16 %0, %1 offset:%2" : "=&v"(dst) : "v"(vb0), "i"(off) : "memory")
#define DA_PV_D0(d0) do { s16x4 l0, l1, l2, l3, h0, h1, h2, h3; constexpr int b_ = VB * SHM_V + v_rd_off(d0, 0, 0); \
        DA_TRRD(l0, b_); DA_TRRD(h0, b_ + 2048); DA_TRRD(l1, b_ + 4096); DA_TRRD(h1, b_ + 6144); DA_TRRD(l2, b_ + 8192); DA_TRRD(h2, b_ + 10240); DA_TRRD(l3, b_ + 12288); DA_TRRD(h3, b_ + 14336); \
        asm volatile("s_waitcnt lgkmcnt(0)" ::: "memory"); DA_SBAR();   \
        o[d0] = __builtin_amdgcn_mfma_f32_32x32x16_bf16(pa0, (bf16x8){l0[0], l0[1], l0[2], l0[3], h0[0], h0[1], h0[2], h0[3]}, o[d0], 0, 0, 0);   \
        o[d0] = __builtin_amdgcn_mfma_f32_32x32x16_bf16(pa1, (bf16x8){l1[0], l1[1], l1[2], l1[3], h1[0], h1[1], h1[2], h1[3]}, o[d0], 0, 0, 0);   \
        o[d0] = __builtin_amdgcn_mfma_f32_32x32x16_bf16(pa2, (bf16x8){l2[0], l2[1], l2[2], l2[3], h2[0], h2[1], h2[2], h2[3]}, o[d0], 0, 0, 0);   \
        o[d0] = __builtin_amdgcn_mfma_f32_32x32x16_bf16(pa3, (bf16x8){l3[0], l3[1], l3[2], l3[3], h3[0], h3[1], h3[2], h3[3]}, o[d0], 0, 0, 0); } while (0)
    DA_PV_D0(0); DA_PV_D0(1); DA_PV_D0(2); DA_PV_D0(3);
#undef DA_PV_D0
#undef DA_TRRD
}
struct BlockRef { const bf16* Q; const bf16* K; const bf16* V; float* O1; bf16* Y; const bf16* SG; int P0; int sub; float slope2; int jlo; };
struct Seam { bf16x8 qr[4]; bf16x8 st_v0, st_v1, st_k0; };
struct Consts { float lam; const float* subln_w; };
#define DA_VMW() asm volatile("s_waitcnt vmcnt(0)" ::: "memory")
#define DA_VMWN(n) asm volatile("s_waitcnt vmcnt(%0)" :: "i"(n) : "memory")
#define DA_SLOAD(Kp, Vp, k0) do { S.st_v0 = *reinterpret_cast<const bf16x8*>((Vp) + (size_t)((k0) + sr) * PV + sc); S.st_v1 = *reinterpret_cast<const bf16x8*>((Vp) + (size_t)((k0) + 32 + sr) * PV + sc); \
                                  S.st_k0 = *reinterpret_cast<const bf16x8*>((Kp) + (size_t)((k0) + ksr) * PK + ksc); } while (0)
#define DA_SWRITE_K(bf) do { *(bf16x8*)(K_lds + (bf) * SHM_K + kws) = S.st_k0; } while (0)
#define DA_SWRITE_V(bf) do { *(bf16x8*)(V_lds + (bf) * SHM_V + vst0) = S.st_v0; *(bf16x8*)(V_lds + (bf) * SHM_V + vst1) = S.st_v1; } while (0)
__device__ __forceinline__ void prime(const BlockRef& cur, char* lds, Seam& S) {
    const int tid = threadIdx.x, wid = __builtin_amdgcn_readfirstlane(tid >> 6), lane = tid & 63, r32 = lane & 31, hi = lane >> 5;
    const int sr = tid >> 4, sc = (tid & 15) * 8, ksr = tid >> 3, ksc = (tid & 7) * 8, kws = DA_KSWZ(ksr, ksc * 2); char* K_lds = lds + 2 * SHM_V;
    const int kb0 = cur.jlo * KVBLK;
#pragma unroll
    for (int d0 = 0; d0 < 4; ++d0) S.qr[d0] = *reinterpret_cast<const bf16x8*>(cur.Q + (size_t)(wid * QBLK + r32) * PQ + d0 * 16 + hi * 8);
    DA_SLOAD(cur.K, cur.V, kb0); DA_VMW(); DA_SWRITE_K(0);
    __syncthreads();
}
__device__ __forceinline__ void block(const BlockRef& cur, const BlockRef& nxt, char* lds, Seam& S, const Consts& C) {
    const int tid = threadIdx.x, wid = __builtin_amdgcn_readfirstlane(tid >> 6), lane = tid & 63, r32 = lane & 31, hi = lane >> 5;
    const int j_lo = cur.jlo, j_hi = (cur.P0 + QB - 1) / KVBLK + 1;
    const int NT = j_hi - j_lo;
    const int kbn = nxt.jlo * KVBLK;
    const int qlo = cur.P0 + wid * QBLK, qm = qlo + r32 - 4 * hi;
    char* V_lds = lds; char* K_lds = lds + 2 * SHM_V;
    float* ws = (float*)(lds + 2 * SHM_V + 2 * SHM_K) + wid * 64; float* li_l = ws, * al_l = ws + 32;
    float m_reg = -1e30f, l_reg = 0; f32x16 o[4] = {};
    const int sr = tid >> 4, sc = (tid & 15) * 8, vst0 = v_st(sr, sc), vst1 = v_st(32 + sr, sc), ksr = tid >> 3, ksc = (tid & 7) * 8, kws = DA_KSWZ(ksr, ksc * 2);
    const int vb0 = (int)(uintptr_t)V_lds + v_rd_base(lane);
    const bf16* Kh = cur.K; const bf16* Vh = cur.V;
    const float slope2 = cur.slope2;
#define DA_RESC(a) do { if (__any((a) < 1.f)) { if (hi == 0) al_l[r32] = (a); asm volatile("s_waitcnt lgkmcnt(0)" ::: "memory");              \
                     for (int d_ = 0; d_ < 4; ++d_) for (int r = 0; r < 16; ++r) o[d_][r] *= al_l[crow(r, hi)]; } } while (0)
#define DA_KBASE(t) ((j_lo + (t)) * KVBLK)
#define DA_BIAS(t) (slope2 * (float)(DA_KBASE(t) - cur.P0 + 4 * hi))
#define DA_MASKT(P0_, P1_, t) do { const int kb_ = DA_KBASE(t); if (kb_ + KVBLK - 1 > qlo) mask_tile(P0_, P1_, qm - kb_); } while (0)
    f32x16 pA0, pA1, pB0, pB1; float alA, alB; bf16x8 pa0, pa1, pa2, pa3;
    DA_SWRITE_V(0); DA_SBAR();
    if (NT > 1) DA_SLOAD(Kh, Vh, DA_KBASE(1));
    DA_SBAR(); qkt<0>(pA0, pA1, K_lds, r32, hi, S.qr, DA_BIAS(0), slope2);
    DA_MASKT(pA0, pA1, 0); partialSM(pA0, pA1, m_reg, alA);
    if (NT > 1) { DA_VMW(); DA_SWRITE_V(1); DA_SWRITE_K(1); }
    __syncthreads();
#define DA_HALF_STEP(PX0, PX1, alX, PY0, PY1, alY, t, KB, VB, SB) do {                                         \
        DA_SBAR(); qkt<KB>(PX0, PX1, K_lds, r32, hi, S.qr, DA_BIAS(t), slope2);                                  \
        finishSM(PY0, PY1, alY, l_reg, pa0, pa1, pa2, pa3); DA_SBAR();                                           \
        if ((t) + 1 < NT) { DA_SLOAD(Kh, Vh, DA_KBASE((t) + 1)); DA_SBAR(); }                                    \
        pv_tile<VB>(o, vb0, pa0, pa1, pa2, pa3); DA_MASKT(PX0, PX1, (t)); partialSM(PX0, PX1, m_reg, alX);       \
        __syncthreads();                                                                                         \
        if ((t) + 1 < NT) { DA_VMW(); DA_SWRITE_V(SB); DA_SWRITE_K(SB); }                                        \
        DA_RESC(alX); __syncthreads(); } while (0)
    for (int t = 1; t + 1 < NT; t += 2) {
        DA_HALF_STEP(pB0, pB1, alB, pA0, pA1, alA, t, 1, 0, 0);
        DA_HALF_STEP(pA0, pA1, alA, pB0, pB1, alB, t + 1, 0, 1, 1);
    }
    const bool even = (NT & 1) == 0;
    if (even) { DA_SBAR(); qkt<1>(pB0, pB1, K_lds, r32, hi, S.qr, DA_BIAS(NT - 1), slope2); DA_SBAR(); }
    DA_SLOAD(nxt.K, nxt.V, kbn); DA_SBAR();
#pragma unroll
    for (int d0 = 0; d0 < 4; ++d0) S.qr[d0] = *reinterpret_cast<const bf16x8*>(nxt.Q + (size_t)(wid * QBLK + r32) * PQ + d0 * 16 + hi * 8);
    DA_SBAR();
    finishSM(pA0, pA1, alA, l_reg, pa0, pa1, pa2, pa3); DA_SBAR();
    pv_tile<0>(o, vb0, pa0, pa1, pa2, pa3);
    if (even) { DA_MASKT(pB0, pB1, NT - 1); partialSM(pB0, pB1, m_reg, alB); __syncthreads(); DA_RESC(alB);
        finishSM(pB0, pB1, alB, l_reg, pa0, pa1, pa2, pa3); DA_SBAR(); pv_tile<1>(o, vb0, pa0, pa1, pa2, pa3); }
    DA_SBAR(); DA_VMWN(4); DA_SWRITE_K(0); DA_SBAR();
    if (hi == 0) li_l[r32] = l_reg; asm volatile("s_waitcnt lgkmcnt(0)" ::: "memory");
    float rli[16];
#pragma unroll
    for (int r = 0; r < 16; ++r) rli[r] = __builtin_amdgcn_rcpf(li_l[crow(r, hi)]);
    float* stg = (float*)(lds + ATT_LDS) + wid * 2048;
    int srow = lane >> 4, scol = (lane & 15) * 4;
    asm volatile("" : "+v"(srow), "+v"(scol));
    typedef float f32x4e __attribute__((ext_vector_type(4)));
    typedef unsigned u32x2e __attribute__((ext_vector_type(2)));
    float* gO = cur.O1 + (size_t)(wid * QBLK + srow) * 512 + scol;
    if (cur.sub == 0) {
#pragma unroll
        for (int hf = 0; hf < 2; ++hf) {
#pragma unroll
            for (int r = 0; r < 16; ++r)
#pragma unroll
                for (int dd = 0; dd < 2; ++dd) stg[crow(r, hi) * 64 + dd * 32 + r32] = o[2 * hf + dd][r] * rli[r];
            asm volatile("s_waitcnt lgkmcnt(0)" ::: "memory");
#pragma unroll
            for (int i = 0; i < 8; ++i) { const f32x4e v = *(const f32x4e*)(stg + (i * 4 + srow) * 64 + scol); *(f32x4e*)(gO + (size_t)i * 4 * 512 + hf * 64) = v; }
            asm volatile("s_waitcnt lgkmcnt(0)" ::: "memory");
        }
    } else {
        const float lam = C.lam; f32x4e dv[2][8]; float ssq[8];
#pragma unroll
        for (int i = 0; i < 8; ++i) ssq[i] = 0.f;
#pragma unroll
        for (int hf = 0; hf < 2; ++hf) {
#pragma unroll
            for (int r = 0; r < 16; ++r)
#pragma unroll
                for (int dd = 0; dd < 2; ++dd) stg[crow(r, hi) * 64 + dd * 32 + r32] = o[2 * hf + dd][r] * rli[r];
            asm volatile("s_waitcnt lgkmcnt(0)" ::: "memory");
#pragma unroll
            for (int i = 0; i < 8; ++i) { const f32x4e v = *(const f32x4e*)(stg + (i * 4 + srow) * 64 + scol); const f32x4e a = *(const f32x4e*)(gO + (size_t)i * 4 * 512 + hf * 64);
                const f32x4e d4 = a - lam * v; dv[hf][i] = d4; ssq[i] += (d4.x * d4.x + d4.y * d4.y) + (d4.z * d4.z + d4.w * d4.w); }
            asm volatile("s_waitcnt lgkmcnt(0)" ::: "memory");
        }
#pragma unroll
        for (int i = 0; i < 8; ++i) { float q = ssq[i]; q += __shfl_xor(q, 1); q += __shfl_xor(q, 2); q += __shfl_xor(q, 4); q += __shfl_xor(q, 8);
            ssq[i] = (1.f - LAM_INIT) * __builtin_amdgcn_rsqf(q * (1.f / 128.f) + EPS); }
        const bf16* sg = cur.SG + (size_t)(wid * QBLK + srow) * 512 + scol; bf16* yw = cur.Y + (size_t)(wid * QBLK + srow) * 1024 + scol;
#pragma unroll
        for (int hf = 0; hf < 2; ++hf) { const f32x4e gw = *(const f32x4e*)(C.subln_w + hf * 64 + scol);
#pragma unroll
            for (int i = 0; i < 8; ++i) { const u32x2e g = *(const u32x2e*)(sg + (size_t)i * 4 * 512 + hf * 64); const f32x4e d4 = dv[hf][i] * ssq[i] * gw; u32x2e w;
                w.x = cvtpk(d4.x * bflo(g.x), d4.y * bfhi(g.x)); w.y = cvtpk(d4.z * bflo(g.y), d4.w * bfhi(g.y));
                *(u32x2e*)(yw + (size_t)i * 4 * 1024 + hf * 64) = w; } }
    }
    __syncthreads();
#undef DA_RESC
#undef DA_KBASE
#undef DA_BIAS
#undef DA_MASKT
#undef DA_HALF_STEP
}
}

__device__ __forceinline__ void simple_gla(Frame& F) {
    LAS float* S = (LAS float*)F.lds;
    LAS float* Qi = S + 8192;
    LAS float* Ki = Qi + 4096;
    LAS float* Kst = Ki + 4096;
    LAS float* Vv = Kst + 4096;
    LAS float* Aa = Vv + 8192;
    LAS float* wtot = Aa + 4096;
    LAS float* dec = wtot + 512;
    const int tid = F.tid, d = tid & 63, w = tid >> 6;
    for (int u = blockIdx.x; u < BATCH * H; u += gridDim.x) {
        const int b = u / H, h = u % H;
        __syncthreads();
        for (int i = tid; i < 8192; i += 512) S[i] = 0.f;
        for (int n = 0; n < T / 64; ++n) {
            const size_t tok0 = (size_t)b * T + n * 64;
            float gl[8]; float run = 0.f;
#pragma unroll
            for (int i = 0; i < 8; ++i) { run += F.Gg[(tok0 + 8 * w + i) * 256 + h * 64 + d]; gl[i] = run; }
            __syncthreads();
            wtot[w * 64 + d] = run;
            __syncthreads();
            float off = 0.f, tot = 0.f;
#pragma unroll
            for (int ww = 0; ww < 8; ++ww) { const float v = wtot[ww * 64 + d]; tot += v; if (ww < w) off += v; }
#pragma unroll
            for (int i = 0; i < 8; ++i) { const int t = 8 * w + i; const float bb = gl[i] + off;
                const float qv = bf2f(F.QB[(tok0 + t) * 256 + h * 64 + d]), kv = bf2f(F.KB[(tok0 + t) * 256 + h * 64 + d]);
                Qi[t * 64 + d] = qv * __expf(bb); Ki[t * 64 + d] = kv * __expf(-bb); Kst[t * 64 + d] = kv * __expf(tot - bb); }
            if (w == 0) dec[d] = __expf(tot);
            { const int t = tid >> 3, seg = (tid & 7) * 16;
#pragma unroll
              for (int q2 = 0; q2 < 2; ++q2) { const v4u x = *(const GAS v4u*)(F.VB + (tok0 + t) * 512 + h * 128 + seg + q2 * 8);
                LAS float* e = Vv + t * 128 + seg + q2 * 8; e[0] = bflo(x.x); e[1] = bfhi(x.x); e[2] = bflo(x.y); e[3] = bfhi(x.y); e[4] = bflo(x.z); e[5] = bfhi(x.z); e[6] = bflo(x.w); e[7] = bfhi(x.w); } }
            __syncthreads();
            { const int c = tid >> 3, s0 = (tid & 7) * 8;
#pragma unroll
              for (int si = 0; si < 8; ++si) { const int s = s0 + si; float a = 0.f;
                  for (int dd = 0; dd < 64; ++dd) a += Qi[c * 64 + dd] * Ki[s * 64 + dd];
                  Aa[c * 64 + s] = (s <= c) ? a : 0.f; } }
            __syncthreads();
            { const int c = tid >> 3, e0 = (tid & 7) * 16; float o[16];
#pragma unroll
              for (int i = 0; i < 16; ++i) o[i] = 0.f;
              for (int s = 0; s < 64; ++s) { const float a = Aa[c * 64 + s], qv = Qi[c * 64 + s];
#pragma unroll
                  for (int i = 0; i < 16; ++i) o[i] += a * Vv[s * 128 + e0 + i] + qv * S[s * 128 + e0 + i]; }
              float ssq = 0.f;
#pragma unroll
              for (int i = 0; i < 16; ++i) ssq += o[i] * o[i];
              ssq += __shfl_xor(ssq, 1); ssq += __shfl_xor(ssq, 2); ssq += __shfl_xor(ssq, 4);
              const float rstd = 1.f / sqrtf(ssq * (1.f / 128.f) + EPS);
              const bf16* sg = F.SGB + (tok0 + c) * 512 + h * 128 + e0; bf16* y = F.Y + (tok0 + c) * 1024 + 512 + h * 128 + e0;
#pragma unroll
              for (int q2 = 0; q2 < 2; ++q2) { const v4u g = *(const GAS v4u*)(sg + q2 * 8); const float* gw = F.gla_w + e0 + q2 * 8; const float* oo = o + q2 * 8; v4u wv;
                  wv.x = pk2(oo[0] * rstd * gw[0] * bflo(g.x), oo[1] * rstd * gw[1] * bfhi(g.x));
                  wv.y = pk2(oo[2] * rstd * gw[2] * bflo(g.y), oo[3] * rstd * gw[3] * bfhi(g.y));
                  wv.z = pk2(oo[4] * rstd * gw[4] * bflo(g.z), oo[5] * rstd * gw[5] * bfhi(g.z));
                  wv.w = pk2(oo[6] * rstd * gw[6] * bflo(g.w), oo[7] * rstd * gw[7] * bfhi(g.w));
                  *(GAS v4u*)(y + q2 * 8) = wv; } }
            __syncthreads();
            { const int dd = tid >> 3, e0 = (tid & 7) * 16; float a[16]; const float dc = dec[dd];
#pragma unroll
              for (int i = 0; i < 16; ++i) a[i] = dc * S[dd * 128 + e0 + i];
              for (int t = 0; t < 64; ++t) { const float kv = Kst[t * 64 + dd];
#pragma unroll
                  for (int i = 0; i < 16; ++i) a[i] += kv * Vv[t * 128 + e0 + i]; }
#pragma unroll
              for (int i = 0; i < 16; ++i) S[dd * 128 + e0 + i] = a[i]; }
        }
    }
    __syncthreads();
}

__device__ __forceinline__ void final_norm(Frame& F) {
    const int gw = F.vcu * NWAVES + F.wave, NGW = F.G * NWAVES;
    f32x4 wv[4];
#pragma unroll
    for (int j = 0; j < 4; ++j) wv[j] = ((const GAS f32x4*)F.fin_w)[F.lane + 64 * j];
    for (int m = gw; m < M; m += NGW) {
        GAS f32x4* zr = (GAS f32x4*)(F.out + (size_t)m * D) + F.lane;
        f32x4 v[4]; float s = 0.f;
#pragma unroll
        for (int j = 0; j < 4; ++j) { v[j] = zr[64 * j]; s += (v[j].x * v[j].x + v[j].y * v[j].y) + (v[j].z * v[j].z + v[j].w * v[j].w); }
        const float rstd = 1.f / sqrtf(wave_sum(s) * (1.f / D) + EPS);
#pragma unroll
        for (int j = 0; j < 4; ++j) zr[64 * j] = v[j] * rstd * wv[j];
    }
}

namespace gla {
typedef short bf16x8 __attribute__((ext_vector_type(8)));
typedef unsigned u32x4 __attribute__((ext_vector_type(4)));
typedef unsigned u32x2 __attribute__((ext_vector_type(2)));
constexpr int RS = 72;
constexpr int L_QI = 0, L_KI = 9216, L_KT = 18432, L_VT = 27648, L_OST = 46080, OSR = 132, L_WTOT = L_OST + 64 * OSR * 4, L_DEC = L_WTOT + 2048, GLA_LDS = L_DEC + 256;
constexpr int GST_STRIDE = 8192 + 64;
typedef float f32x2_t __attribute__((ext_vector_type(2))); typedef __bf16 bf16x2_t __attribute__((ext_vector_type(2)));
__device__ __forceinline__ unsigned cvtpk(float lo, float hi) { f32x2_t v = {lo, hi}; bf16x2_t b = __builtin_convertvector(v, bf16x2_t); return __builtin_bit_cast(unsigned, b); }
__device__ __forceinline__ bf16x8 pack8(f32x4 a, f32x4 b) { u32x4 w = {cvtpk(a[0], a[1]), cvtpk(a[2], a[3]), cvtpk(b[0], b[1]), cvtpk(b[2], b[3])}; return __builtin_bit_cast(bf16x8, w); }
__device__ __forceinline__ bf16x8 join8(u32x2 a, u32x2 b) { u32x4 w = {a.x, a.y, b.x, b.y}; return __builtin_bit_cast(bf16x8, w); }
#define GLA_MFMA(a, b, c) __builtin_amdgcn_mfma_f32_16x16x32_bf16(a, b, c, 0, 0, 0)
template <bool OUT>
__device__ __forceinline__ void unit(Frame& F, char* ldsg, int b, int h, int sc) {
    LAS unsigned char* lds = (LAS unsigned char*)F.lds;
    LAS bf16* QI = (LAS bf16*)(lds + L_QI); LAS bf16* KI = (LAS bf16*)(lds + L_KI); LAS bf16* KT = (LAS bf16*)(lds + L_KT); LAS bf16* VT = (LAS bf16*)(lds + L_VT);
    LAS float* OST = (LAS float*)(lds + L_OST); LAS float* wtot = (LAS float*)(lds + L_WTOT); LAS float* dec = (LAS float*)(lds + L_DEC);
    const int tid = F.tid, lane = F.lane, w = F.wave, n = lane & 15, g = lane >> 4;
    const int bh = b * H + h;
    f32x4 S[4];
#pragma unroll
    for (int td = 0; td < 4; ++td) S[td] = (f32x4){0.f, 0.f, 0.f, 0.f};
    float logD = 0.f;
    if (OUT) {
        for (int s2 = 0; s2 < sc; ++s2) { const float* gs = F.GST + (size_t)(bh * 8 + s2) * GST_STRIDE;
#pragma unroll
            for (int td = 0; td < 4; ++td) { const f32x4 dl = *(const GAS f32x4*)(gs + 8192 + 16 * td + 4 * g);
#pragma unroll
                for (int r = 0; r < 4; ++r) S[td][r] = __expf(dl[r]) * S[td][r] + gs[(16 * td + 4 * g + r) * 128 + 16 * w + n]; } }
    }
    float gwv[16];
    if (OUT) {
#pragma unroll
        for (int i = 0; i < 16; ++i) gwv[i] = F.gla_w[(tid & 7) * 16 + i];
    }
    __syncthreads();
    for (int ch = 0; ch < 16; ++ch) {
        const size_t tok0 = (size_t)b * T + sc * 1024 + ch * 64;
        float gl[8]; float run = 0.f;
#pragma unroll
        for (int i = 0; i < 8; ++i) { run += F.Gg[(tok0 + 8 * w + i) * 256 + h * 64 + lane]; gl[i] = run; }
        unsigned short kk[8], qq[8];
#pragma unroll
        for (int i = 0; i < 8; ++i) { kk[i] = F.KB[(tok0 + 8 * w + i) * 256 + h * 64 + lane]; if (OUT) qq[i] = F.QB[(tok0 + 8 * w + i) * 256 + h * 64 + lane]; }
        const v4u v0 = *(const GAS v4u*)(F.VB + (tok0 + lane) * 512 + h * 128 + 16 * w), v1 = *(const GAS v4u*)(F.VB + (tok0 + lane) * 512 + h * 128 + 16 * w + 8);
        wtot[w * 64 + lane] = run;
        __syncthreads();
        float off = 0.f, tot = 0.f;
#pragma unroll
        for (int ww = 0; ww < 8; ++ww) { const float x = wtot[ww * 64 + lane]; tot += x; if (ww < w) off += x; }
        float kst[8];
#pragma unroll
        for (int i = 0; i < 8; ++i) { const int t = 8 * w + i; const float bb = gl[i] + off; const float kv = bf2f(kk[i]);
            kst[i] = kv * __expf(tot - bb);
            if (OUT) { QI[t * RS + lane] = (bf16)f2bf(bf2f(qq[i]) * __expf(bb)); KI[t * RS + lane] = (bf16)f2bf(kv * __expf(-bb)); } }
        { u32x4 pk = {cvtpk(kst[0], kst[1]), cvtpk(kst[2], kst[3]), cvtpk(kst[4], kst[5]), cvtpk(kst[6], kst[7])}; *(LAS u32x4*)(KT + lane * RS + 8 * w) = pk; }
        if (w == 0) dec[lane] = __expf(tot);
        { const unsigned vv[8] = {v0.x, v0.y, v0.z, v0.w, v1.x, v1.y, v1.z, v1.w};
#pragma unroll
          for (int i = 0; i < 8; ++i) { VT[(16 * w + 2 * i) * RS + lane] = (bf16)(vv[i] & 0xffffu); VT[(16 * w + 2 * i + 1) * RS + lane] = (bf16)(vv[i] >> 16); } }
        logD += tot;
        __syncthreads();
        f32x4 o[4];
        if (OUT) {
            bf16x8 af[4][2];
#pragma unroll
            for (int tc = 0; tc < 4; ++tc) {
                f32x4 at[4];
#pragma unroll
                for (int ts = 0; ts < 4; ++ts) { at[ts] = (f32x4){0.f, 0.f, 0.f, 0.f};
                    if (ts <= tc) {
#pragma unroll
                        for (int ks = 0; ks < 2; ++ks) { const bf16x8 A = *(const LAS bf16x8*)(KI + (16 * ts + n) * RS + 32 * ks + 8 * g), B = *(const LAS bf16x8*)(QI + (16 * tc + n) * RS + 32 * ks + 8 * g);
                            at[ts] = GLA_MFMA(A, B, at[ts]); }
                        if (ts == tc) {
#pragma unroll
                            for (int r = 0; r < 4; ++r) if (4 * g + r > n) at[ts][r] = 0.f; } } }
                af[tc][0] = pack8(at[0], at[1]); af[tc][1] = pack8(at[2], at[3]);
            }
#pragma unroll
            for (int tc = 0; tc < 4; ++tc) { o[tc] = (f32x4){0.f, 0.f, 0.f, 0.f};
#pragma unroll
                for (int ks = 0; ks < 2; ++ks) if (2 * ks <= tc) {
                    const u32x2 b0 = *(const LAS u32x2*)(VT + (16 * w + n) * RS + 32 * ks + 4 * g), b1 = *(const LAS u32x2*)(VT + (16 * w + n) * RS + 32 * ks + 16 + 4 * g);
                    o[tc] = GLA_MFMA(af[tc][ks], join8(b0, b1), o[tc]); } }
            const bf16x8 Sb0 = pack8(S[0], S[1]), Sb1 = pack8(S[2], S[3]);
#pragma unroll
            for (int tc = 0; tc < 4; ++tc) {
#pragma unroll
                for (int ks = 0; ks < 2; ++ks) {
                    const u32x2 a0 = *(const LAS u32x2*)(QI + (16 * tc + n) * RS + 32 * ks + 4 * g), a1 = *(const LAS u32x2*)(QI + (16 * tc + n) * RS + 32 * ks + 16 + 4 * g);
                    o[tc] = GLA_MFMA(join8(a0, a1), ks ? Sb1 : Sb0, o[tc]); } }
        }
#pragma unroll
        for (int td = 0; td < 4; ++td) { const f32x4 d4 = *(const LAS f32x4*)(dec + 16 * td + 4 * g); S[td] = S[td] * d4;
#pragma unroll
            for (int ks = 0; ks < 2; ++ks) { const bf16x8 A = *(const LAS bf16x8*)(KT + (16 * td + n) * RS + 32 * ks + 8 * g), B = *(const LAS bf16x8*)(VT + (16 * w + n) * RS + 32 * ks + 8 * g);
                S[td] = GLA_MFMA(A, B, S[td]); } }
        if (OUT) {
#pragma unroll
            for (int tc = 0; tc < 4; ++tc)
#pragma unroll
                for (int r = 0; r < 4; ++r) OST[(16 * tc + 4 * g + r) * OSR + 16 * w + n] = o[tc][r];
            __syncthreads();
            const int c = tid >> 3, seg = (tid & 7) * 16;
            f32x4 ov[4]; float ssq = 0.f;
#pragma unroll
            for (int i = 0; i < 4; ++i) { ov[i] = *(const LAS f32x4*)(OST + c * OSR + seg + 4 * i); ssq += (ov[i].x * ov[i].x + ov[i].y * ov[i].y) + (ov[i].z * ov[i].z + ov[i].w * ov[i].w); }
            ssq += __shfl_xor(ssq, 1); ssq += __shfl_xor(ssq, 2); ssq += __shfl_xor(ssq, 4);
            const float rstd = __builtin_amdgcn_rsqf(ssq * (1.f / 128.f) + EPS);
            const bf16* sg = F.SGB + (tok0 + c) * 512 + h * 128 + seg; bf16* y = F.Y + (tok0 + c) * 1024 + 512 + h * 128 + seg;
#pragma unroll
            for (int q2 = 0; q2 < 2; ++q2) { const v4u gt = *(const GAS v4u*)(sg + q2 * 8); const f32x4 a0 = ov[2 * q2] * rstd, a1 = ov[2 * q2 + 1] * rstd; const float* gw = gwv + q2 * 8; v4u wv;
                wv.x = cvtpk(a0.x * gw[0] * bflo(gt.x), a0.y * gw[1] * bfhi(gt.x)); wv.y = cvtpk(a0.z * gw[2] * bflo(gt.y), a0.w * gw[3] * bfhi(gt.y));
                wv.z = cvtpk(a1.x * gw[4] * bflo(gt.z), a1.y * gw[5] * bfhi(gt.z)); wv.w = cvtpk(a1.z * gw[6] * bflo(gt.w), a1.w * gw[7] * bfhi(gt.w));
                *(GAS v4u*)(y + q2 * 8) = wv; }
        }
    }
    if (!OUT) {
        float* gs = F.GST + (size_t)(bh * 8 + sc) * GST_STRIDE;
#pragma unroll
        for (int td = 0; td < 4; ++td)
#pragma unroll
            for (int r = 0; r < 4; ++r) gs[(16 * td + 4 * g + r) * 128 + 16 * w + n] = S[td][r];
        if (w == 0) gs[8192 + lane] = logD;
    }
    __syncthreads();
}
}

__device__ __forceinline__ da::BlockRef attn_ref(Frame& F, int seq) {
    const int item = F.vcu + (seq >> 2) * F.G;
    const int bh = item >> 4, p = item & 15, b = bh >> 2, h = bh & 3;
    const int qb = ((seq >> 1) & 1) ? 31 - p : p, sub = seq & 1;
    const size_t row0 = (size_t)b * T + (size_t)qb * da::QB;
    da::BlockRef r;
    r.Q = F.QA + row0 * 512 + h * 128 + sub * 64;
    r.K = F.KA + (size_t)b * T * 512 + h * 128 + sub * 64;
    r.V = F.VA + (size_t)b * T * 512 + h * 128;
    r.O1 = F.O1 + row0 * 512 + h * 128; r.Y = F.Y + row0 * 1024 + h * 128; r.SG = F.SGA + row0 * 512 + h * 128;
    r.P0 = qb * da::QB; r.sub = sub; r.slope2 = exp2f(-2.f * (float)(h + 1)) * LOG2E; r.jlo = 0;
    return r;
}
__device__ __forceinline__ void fast_attn(Frame& F, char* lds) {
    da::Consts C; C.lam = lambda_full(F); C.subln_w = F.subln_w;
    da::Seam S;
    da::BlockRef cur = attn_ref(F, 0);
    da::prime(cur, lds, S);
    for (int seq = 0; seq < 8; ++seq) {
        const da::BlockRef nxt = (seq + 1 < 8) ? attn_ref(F, seq + 1) : cur;
        da::block(cur, nxt, lds, S, C);
        cur = nxt;
    }
    asm volatile("s_waitcnt vmcnt(0)" ::: "memory");
    __syncthreads();
}

struct Args { const float* in[13]; float* out; unsigned char* ws; int ph_lo, ph_hi, li, pad; };
__global__ void __launch_bounds__(NWAVES * 64, 2) hybrid_fwd(Args args) {
    extern __shared__ __attribute__((aligned(16))) unsigned char lds[];
    Frame F;
    F.lds = (LAS unsigned char*)lds;
    F.MISC = (volatile LAS unsigned*)(F.lds + MISC_OFF);
    F.tid = threadIdx.x; F.lane = F.tid & 63; F.wave = __builtin_amdgcn_readfirstlane(F.tid >> 6);
    F.G = gridDim.x; { const int bx = blockIdx.x; F.vcu = (F.G % 8 == 0) ? (bx % 8) * (F.G / 8) + bx / 8 : bx; }
    unsigned char* ws = args.ws;
    F.ctl = (gu32*)(ws + WS_CTL);
    F.x = args.in[0]; F.norm_w = args.in[1]; F.w_in = args.in[2]; F.w_gate_up = args.in[3]; F.b_gate = args.in[4];
    F.lq1 = args.in[5]; F.lk1 = args.in[6]; F.lq2 = args.in[7]; F.lk2 = args.in[8]; F.subln_w = args.in[9]; F.gla_w = args.in[10];
    F.w_out = args.in[11]; F.fin_w = args.in[12]; F.out = args.out;
    F.Win_t = (bf16*)(ws + WS_WIN); F.Wout_t = (bf16*)(ws + WS_WOUT); F.XN = (bf16*)(ws + WS_XN); F.Y = (bf16*)(ws + WS_Y);
    F.QA = (bf16*)(ws + WS_QA); F.KA = (bf16*)(ws + WS_KA); F.VA = (bf16*)(ws + WS_VA); F.SGA = (bf16*)(ws + WS_SGA);
    F.QB = (bf16*)(ws + WS_QB); F.KB = (bf16*)(ws + WS_KB); F.VB = (bf16*)(ws + WS_VB); F.SGB = (bf16*)(ws + WS_SGB);
    F.Gg = (float*)(ws + WS_G); F.O1 = (float*)(ws + WS_O1); F.GST = (float*)(ws + WS_GST);
    for (int u = F.tid; u < (LDS_BYTES - LDSCTL_OFF) / 4; u += NWAVES * 64) ((LAS unsigned*)(F.lds + LDSCTL_OFF))[u] = 0u;
    __syncthreads();
    XcdBarrier bar; bar.bar = (unsigned*)(F.ctl + CW_BAR); bar.x = 0; bar.st = nullptr;
    if (N_LAUNCHES != PER_PHASE) bar = xcd_barrier_post((unsigned*)(F.ctl + CW_BAR), F.MISC + 8);
#define GRID_BAR(seam) do { if (N_LAUNCHES == PER_PHASE) { if (F.tid == 0) __hip_atomic_store(F.ctl + CW_TMO, 0xBADBA0u | (unsigned)(seam), RLX_AGENT); } else { xcd_barrier(bar); } } while (0)
    const int lo = args.ph_lo, hi = args.ph_hi;
#define IN(k) (lo <= (k) && (k) < hi)
#define BOTH(k) (IN(k) && IN((k) + 1))
    if (IN(0)) { p0_prologue(F); if (BOTH(0)) GRID_BAR(0); }
    if (IN(1)) {
        pg8::Gemm g{F.XN, F.Win_t, M, NP, D}; pg8::StaticOrder S; S.init(M, NP, F.G, (int)blockIdx.x);
        pg8::EpiProjFast E{F.QA, F.KA, F.VA, F.SGA, F.QB, F.KB, F.VB, F.SGB, F.Gg, F.b_gate};
        pg8::gemm_phase<pg8::EpiProjFast, pg8::StaticOrder, true, true>(F.lds, g, S, E);
        if (BOTH(1)) GRID_BAR(1);
    }
    if (IN(2)) { if (F.G == 256 && (F.vcu & 7) != 7) gla::unit<false>(F, (char*)lds, F.vcu >> 5, (F.vcu >> 3) & 3, F.vcu & 7); if (BOTH(2)) GRID_BAR(2); }
    if (IN(3)) { if (F.G == 256) { fast_attn(F, (char*)lds); gla::unit<true>(F, (char*)lds, F.vcu >> 5, (F.vcu >> 3) & 3, F.vcu & 7); } else { simple_attn(F); simple_gla(F); } if (BOTH(3)) GRID_BAR(3); }
    if (IN(4)) {
        pg8::Gemm g{F.Y, F.Wout_t, M, D, D}; pg8::StaticOrder S; S.init(M, D, F.G, (int)blockIdx.x);
        pg8::EpiResFast E{F.x, F.out};
        pg8::gemm_phase<pg8::EpiResFast, pg8::StaticOrder, true, true>(F.lds, g, S, E);
        if (BOTH(4)) GRID_BAR(4);
    }
    if (IN(5)) { final_norm(F); }
#undef IN
#undef BOTH
}

extern "C" void kernel_launch(void* const* d_in, const int* in_sizes, int n_in, void* d_out, int out_size, void* d_ws, size_t ws_size, hipStream_t stream) {
    static int grid = 0;
    if (grid == 0) {
        if (n_in != 13 || in_sizes[0] != M * D || out_size != M * D || ws_size < WS_END) { fprintf(stderr, "kernel_launch: shape/workspace mismatch (n_in %d, in0 %d, out %d, ws %zu)\n", n_in, n_in > 0 ? in_sizes[0] : -1, out_size, ws_size); grid = -1; return; }
        int dev = 0, cus = 0, per_cu = 0;
        if (hipGetDevice(&dev) != hipSuccess || hipDeviceGetAttribute(&cus, hipDeviceAttributeMultiprocessorCount, dev) != hipSuccess) { grid = -1; return; }
        if (hipFuncSetAttribute((const void*)hybrid_fwd, hipFuncAttributeMaxDynamicSharedMemorySize, LDS_BYTES) != hipSuccess) { fprintf(stderr, "kernel_launch: hipFuncSetAttribute failed\n"); grid = -1; return; }
        if (hipOccupancyMaxActiveBlocksPerMultiprocessor(&per_cu, (const void*)hybrid_fwd, NWAVES * 64, LDS_BYTES) != hipSuccess || per_cu < 1) { fprintf(stderr, "kernel_launch: occupancy query says %d\n", per_cu); per_cu = 1; }
        (void)hipGetLastError();
        grid = cus;
    }
    if (grid < 0) return;
    (void)hipMemsetAsync((char*)d_ws + WS_CTL, 0, CTL_ZERO_BYTES, stream);
    Args a{};
    for (int i = 0; i < 13; ++i) a.in[i] = (const float*)d_in[i];
    a.out = (float*)d_out; a.ws = (unsigned char*)d_ws;
    if (N_LAUNCHES == 1) { a.ph_lo = 0; a.ph_hi = PER_PHASE; a.li = 0; hipLaunchKernelGGL(hybrid_fwd, dim3(grid), dim3(NWAVES * 64), LDS_BYTES, stream, a); }
    else for (int li = 0; li < PER_PHASE; ++li) { a.ph_lo = li; a.ph_hi = li + 1; a.li = li; hipLaunchKernelGGL(hybrid_fwd, dim3(grid), dim3(NWAVES * 64), LDS_BYTES, stream, a); }
}
```

```cpp
#include <hip/hip_runtime.h>
#include <cstdio>
#include <cstdint>

#ifndef MK_N_LAUNCHES
#define MK_N_LAUNCHES 1
#endif
constexpr int N_LAUNCHES = MK_N_LAUNCHES;
constexpr int PER_PHASE = 6;
constexpr int NWAVES = 8;

constexpr int BATCH = 8, T = 8192, D = 1024, M = BATCH * T;
constexpr int H = 4;
constexpr int IN_COLS = 3600;
constexpr int NP = 3840;
constexpr float EPS = 1e-6f;
constexpr float LOG2E = 1.4426950408889634f;
constexpr float C2 = 0.125f * LOG2E;
constexpr float LAM_INIT = 0.2f;

constexpr size_t MiB = 1u << 20;
constexpr size_t WS_CTL = 0, CTL_ZERO_BYTES = 1 * MiB;
constexpr size_t WS_WIN = 2 * MiB;
constexpr size_t WS_WOUT = 10 * MiB;
constexpr size_t WS_GST = 16 * MiB;
constexpr size_t WS_XN = 32 * MiB;
constexpr size_t WS_Y = 160 * MiB;
constexpr size_t WS_QA = 288 * MiB, WS_KA = 352 * MiB, WS_VA = 416 * MiB, WS_SGA = 480 * MiB;
constexpr size_t WS_QB = 544 * MiB, WS_KB = 576 * MiB;
constexpr size_t WS_VB = 608 * MiB, WS_SGB = 672 * MiB;
constexpr size_t WS_G = 736 * MiB;
constexpr size_t WS_O1 = 800 * MiB;
constexpr size_t WS_END = 928 * MiB;
constexpr int CW_TMO = 0, CW_CODE = 1, CW_BAR = 4096;
constexpr int CW_KM = 16384, CW_QM = 16640, CW_QCTR = 24576;
constexpr float SKIP_THRL = 40.f;

constexpr int RING_BYTES = 147456;
constexpr int LDSCTL_OFF = RING_BYTES, MISC_OFF = LDSCTL_OFF + 320;
constexpr int LDS_BYTES = RING_BYTES + 1024;

#define GAS __attribute__((address_space(1)))
#define LAS __attribute__((address_space(3)))
typedef unsigned short bf16;
typedef unsigned v4u __attribute__((ext_vector_type(4)));
typedef float f32x4 __attribute__((ext_vector_type(4)));
typedef GAS unsigned gu32;
#define RLX_AGENT __ATOMIC_RELAXED, __HIP_MEMORY_SCOPE_AGENT
#define LDS_WAIT() asm volatile("s_waitcnt lgkmcnt(0)" ::: "memory")
#define VM_WAIT() asm volatile("s_waitcnt vmcnt(0)" ::: "memory")

__device__ __forceinline__ unsigned f2bf(float f) { unsigned u = __builtin_bit_cast(unsigned, f); return (u + 0x7fffu + ((u >> 16) & 1u)) >> 16; }
__device__ __forceinline__ unsigned pk2(float lo, float hi) { return f2bf(lo) | (f2bf(hi) << 16); }
__device__ __forceinline__ float bf2f(unsigned short b) { return __builtin_bit_cast(float, (unsigned)b << 16); }
__device__ __forceinline__ float bflo(unsigned w) { return __builtin_bit_cast(float, w << 16); }
__device__ __forceinline__ float bfhi(unsigned w) { return __builtin_bit_cast(float, w & 0xffff0000u); }
__device__ __forceinline__ float silu_f(float v) { return v / (1.f + __expf(-v)); }
__device__ __forceinline__ float logsigmoid_f(float v) { return fminf(v, 0.f) - log1pf(__expf(-fabsf(v))); }

#define XB_TMO      128
#define XB_XCNT(j)  (256  + 64 * (j))
#define XB_XSUB(j)  (1280 + 64 * (j))
#define XB_XGEN(j)  (2304 + 64 * (j))
#define XB_TOP      3328
#define XB_TOPGEN   3392
#define XCD_BAR_WORDS 3456
#define XB_SPIN_CAP (1u << 22)
__device__ __forceinline__ unsigned xb_ld(unsigned* p)              { return __hip_atomic_load(p, __ATOMIC_RELAXED, __HIP_MEMORY_SCOPE_AGENT); }
__device__ __forceinline__ unsigned xb_add(unsigned* p, unsigned v) { return __hip_atomic_fetch_add(p, v, __ATOMIC_RELAXED, __HIP_MEMORY_SCOPE_AGENT); }
__device__ __forceinline__ unsigned xb_xcc_id() { return (unsigned)__builtin_amdgcn_s_getreg((3 << 11) | 20) & 0xFu; }
#define XB_SPIN(cond, bar) do { unsigned _sp = 0; while (cond) { __builtin_amdgcn_s_sleep(1); \
    if ((++_sp & 255u) == 0u) { if (xb_ld(&(bar)[XB_TMO])) break; if (_sp > XB_SPIN_CAP) { atomicAdd(&(bar)[XB_TMO], 1u); break; } } } } while (0)
struct XcdBarrier { unsigned* bar; unsigned x; volatile LAS unsigned* st; };
__device__ __forceinline__ XcdBarrier xcd_barrier_post(unsigned* bar, volatile LAS unsigned* st) {
    XcdBarrier b; b.bar = bar; b.x = xb_xcc_id(); b.st = st;
    if (threadIdx.x == 0) (void)xb_add(&bar[XB_XCNT(b.x)], 1u);
    return b;
}
__device__ __forceinline__ void xcd_barrier_complete(unsigned* bar, unsigned x, unsigned& nloc, unsigned& nx) {
    const unsigned G = gridDim.x * gridDim.y * gridDim.z;
    unsigned sum, cnt, mine, sp = 0u;
    for (;;) {
        sum = 0u; cnt = 0u; mine = 0u;
#pragma unroll
        for (unsigned j = 0; j < 16; ++j) { const unsigned c = xb_ld(&bar[XB_XCNT(j)]); sum += c; cnt += (c > 0u) ? 1u : 0u; mine = (j == x) ? c : mine; }
        if (sum == G) break;
        __builtin_amdgcn_s_sleep(1);
        if ((++sp & 255u) == 0u) { if (xb_ld(&bar[XB_TMO])) break; if (sp > XB_SPIN_CAP) { atomicAdd(&bar[XB_TMO], 1u); break; } }
    }
    nloc = mine > 0u ? mine : 1u; nx = cnt > 0u ? cnt : 1u;
}
__device__ __forceinline__ void xcd_barrier(const XcdBarrier& b) {
    asm volatile("s_waitcnt vmcnt(0)" ::: "memory");
    __syncthreads();
    if (threadIdx.x == 0) {
        unsigned* bar = b.bar;
        __builtin_amdgcn_s_waitcnt(0);
        unsigned nloc = b.st[0], nx = b.st[1];
        if (nloc == 0u) { xcd_barrier_complete(bar, b.x, nloc, nx); b.st[0] = nloc; b.st[1] = nx; }
        const unsigned old = xb_add(&bar[XB_XSUB(b.x)], 1u);
        const unsigned gen = old / nloc;
        if (old + 1u == (gen + 1u) * nloc) {
            __builtin_amdgcn_fence(__ATOMIC_RELEASE, "agent");
            asm volatile("s_waitcnt vmcnt(0)" ::: "memory");
            const unsigned og = xb_add(&bar[XB_TOP], 1u);
            const unsigned tg = og / nx;
            if (og + 1u == (tg + 1u) * nx) xb_add(&bar[XB_TOPGEN], 1u);
            else XB_SPIN(xb_ld(&bar[XB_TOPGEN]) == tg, bar);
            __builtin_amdgcn_fence(__ATOMIC_ACQUIRE, "agent");
            xb_add(&bar[XB_XGEN(b.x)], 1u);
            asm volatile("s_waitcnt vmcnt(0)" ::: "memory");
        } else {
            XB_SPIN(xb_ld(&bar[XB_XGEN(b.x)]) == gen, bar);
            __builtin_amdgcn_fence(__ATOMIC_ACQUIRE, "agent");
            asm volatile("s_waitcnt vmcnt(0)" ::: "memory");
        }
    }
    __syncthreads();
}

namespace pg8 {
#define PG8_LAS __attribute__((address_space(3)))
typedef unsigned short bf16_t;
typedef short bf16x8 __attribute__((ext_vector_type(8)));
typedef float f32x4 __attribute__((ext_vector_type(4)));
typedef unsigned u32x4 __attribute__((ext_vector_type(4)));
constexpr int BM = 256, BK = 64, HALF = 128, HTB = HALF * BK * 2  , STAGE_BYTES = 8 * HTB, NXCD = 8, WGM = 8;

__host__ __device__ __forceinline__ int lds_byte(int r, int c) { const int st = (r >> 4) * 2 + (c >> 5), rr = r & 15, cc = c & 31, ob = rr * 64 + cc * 2; return st * 1024 + (ob ^ (((ob >> 9) & 1) << 5)); }
__host__ __device__ __forceinline__ void stage_rc(int b, int& R, int& C) { const int st = b / 1024, sb = b % 1024, swz = sb ^ (((sb >> 9) & 1) << 5); R = (st >> 1) * 16 + swz / 64; C = (st & 1) * 32 + (swz % 64) / 2; }
__host__ __device__ __forceinline__ int perm32(int rho) { const int n = rho >> 4, i = rho & 15; return 8 * (i >> 2) + 4 * n + (i & 3); }

struct Unit { int pm, pn; };
struct Gemm { const bf16_t* A; const bf16_t* Bt; int M, N, K; };

struct StaticOrder {
    int nM, nN, nwg, G, c;
    __host__ __device__ void init(int M, int N, int G_, int c_) { nM = M / BM; nN = N / BM; nwg = nM * nN; G = G_; c = c_; }
    __host__ __device__ bool next(int i, Unit& u) const {
        const long L = (long)i * G + c; if (L >= nwg) return false;
        int wgid = (int)L; { const int q = nwg / NXCD, r = nwg % NXCD, xcd = wgid % NXCD, off = wgid / NXCD; wgid = (xcd < r ? xcd * (q + 1) : r * (q + 1) + (xcd - r) * q) + off; }
        const int nig = WGM * nN, gid = wgid / nig, fm = gid * WGM, gsz = (nM - fm) < WGM ? (nM - fm) : WGM;
        u.pm = fm + ((wgid % nig) % gsz); u.pn = (wgid % nig) / gsz; return true;
    }
    __device__ __forceinline__ void a_ready(const Unit&) const {}
    __device__ __forceinline__ void done(const Unit&) const {}
};


__device__ __forceinline__ unsigned cvt_pk_bf16(float lo, float hi) { unsigned r; asm volatile("v_cvt_pk_bf16_f32 %0, %1, %2" : "=v"(r) : "v"(lo), "v"(hi)); return r; }

struct EpiProjFast {
    static constexpr bool PERM = true, AFTER_DRAIN = false;
    bf16_t *QA, *KA, *VA, *SGA, *QB, *KB, *VB, *SGB; float* Gg; const float* b_gate; unsigned* km; unsigned* qm;
    __device__ __forceinline__ void operator()(const f32x4 (&acc)[2][2][4][2], const Unit& u, int wr, int wc, int fr, int fq) const {
        const int pn = u.pn, row0 = u.pm * BM + wr * 64 + fr, col0 = wc * 32 + 8 * fq;
        if (pn < 4) {
            const float scq = pn < 2 ? C2 : 1.f; const int bb = u.pm >> 5, qb = u.pm & 31;
#pragma unroll
            for (int bj = 0; bj < 2; ++bj) { float mx = 0.f;
#pragma unroll
                for (int ai = 0; ai < 2; ++ai)
#pragma unroll
                    for (int m = 0; m < 4; ++m) { const f32x4 v0 = acc[ai][bj][m][0] * scq, v1 = acc[ai][bj][m][1] * scq;
                        float q = (v0[0] * v0[0] + v0[1] * v0[1]) + (v0[2] * v0[2] + v0[3] * v0[3]) + (v1[0] * v1[0] + v1[1] * v1[1]) + (v1[2] * v1[2] + v1[3] * v1[3]);
                        q += __shfl_xor(q, 16); q += __shfl_xor(q, 32); mx = fmaxf(mx, q); }
                mx = fmaxf(mx, __shfl_xor(mx, 1)); mx = fmaxf(mx, __shfl_xor(mx, 2)); mx = fmaxf(mx, __shfl_xor(mx, 4)); mx = fmaxf(mx, __shfl_xor(mx, 8));
                if (fr == 0 && fq == 0) { const int idx = (bb * 4 + 2 * (pn & 1) + bj) * 2 + (wc >> 1);
                    if (pn < 2) atomicMax(qm + (idx * 32 + qb) * 2 + (wc & 1), __float_as_uint(mx)); else atomicMax(km + idx * 2 + (wc & 1), __float_as_uint(mx)); } }
        }
        if (pn == 14) {
            f32x4 bv[2][2];
#pragma unroll
            for (int bj = 0; bj < 2; ++bj)
#pragma unroll
                for (int n = 0; n < 2; ++n) bv[bj][n] = *(const f32x4*)(b_gate + col0 + bj * HALF + 4 * n);
#pragma unroll
            for (int ai = 0; ai < 2; ++ai)
#pragma unroll
                for (int m = 0; m < 4; ++m) { float* rowp = Gg + (size_t)(row0 + ai * HALF + m * 16) * 256 + col0;
#pragma unroll
                    for (int bj = 0; bj < 2; ++bj)
#pragma unroll
                        for (int n = 0; n < 2; ++n) { f32x4 v = acc[ai][bj][m][n] + bv[bj][n];
#pragma unroll
                            for (int e = 0; e < 4; ++e) v[e] = logsigmoid_f(v[e]) * (1.f / 16.f);
                            *(f32x4*)(rowp + bj * HALF + 4 * n) = v; } }
            return;
        }
        bf16_t* base; int ldc = 512, cofs; float sc = 1.f; bool act = false;
        if (pn < 2) { base = QA; cofs = pn * 256; sc = C2; }
        else if (pn < 4) { base = KA; cofs = (pn - 2) * 256; }
        else if (pn < 6) { base = VA; cofs = (pn - 4) * 256; }
        else if (pn < 8) { base = SGA; cofs = (pn - 6) * 256; act = true; }
        else if (pn == 8) { base = QB; ldc = 256; cofs = 0; sc = 0.125f; }
        else if (pn == 9) { base = KB; ldc = 256; cofs = 0; }
        else if (pn < 12) { base = VB; cofs = (pn - 10) * 256; }
        else { base = SGB; cofs = (pn - 12) * 256; act = true; }
#pragma unroll
        for (int ai = 0; ai < 2; ++ai)
#pragma unroll
            for (int m = 0; m < 4; ++m) { bf16_t* rowp = base + (size_t)(row0 + ai * HALF + m * 16) * ldc + cofs + col0;
#pragma unroll
                for (int bj = 0; bj < 2; ++bj) { f32x4 v0 = acc[ai][bj][m][0], v1 = acc[ai][bj][m][1];
                    if (act) {
#pragma unroll
                        for (int e = 0; e < 4; ++e) { v0[e] = v0[e] * __builtin_amdgcn_rcpf(1.f + __expf(-v0[e])); v1[e] = v1[e] * __builtin_amdgcn_rcpf(1.f + __expf(-v1[e])); }
                    } else { v0 = v0 * sc; v1 = v1 * sc; }
                    u32x4 w; w.x = cvt_pk_bf16(v0[0], v0[1]); w.y = cvt_pk_bf16(v0[2], v0[3]); w.z = cvt_pk_bf16(v1[0], v1[1]); w.w = cvt_pk_bf16(v1[2], v1[3]);
                    *(u32x4*)(rowp + bj * HALF) = w; } }
    }
};
struct EpiResFast {
    static constexpr bool PERM = false, AFTER_DRAIN = false;
    const float* x; float* out;
    __device__ __forceinline__ void operator()(const f32x4 (&acc)[2][2][4][2], const Unit& u, int wr, int wc, int fr, int fq) const {
        const int row0 = u.pm * BM + wr * 64 + fr, col0 = u.pn * BM + wc * 32 + 4 * fq;
#pragma unroll
        for (int ai = 0; ai < 2; ++ai)
#pragma unroll
            for (int m = 0; m < 4; ++m) { const size_t off = (size_t)(row0 + ai * HALF + m * 16) * 1024 + col0;
#pragma unroll
                for (int bj = 0; bj < 2; ++bj)
#pragma unroll
                    for (int n = 0; n < 2; ++n) { const size_t i = off + bj * HALF + n * 16; *(f32x4*)(out + i) = *(const f32x4*)(x + i) + acc[ai][bj][m][n]; } }
    }
};
template <class Epi, class Sched, bool ALIGN_EPI = false, bool SP2 = false>
__device__ __forceinline__ void gemm_phase(PG8_LAS unsigned char* lds, const Gemm g, const Sched& S, const Epi& E) {
    const int tid = threadIdx.x, wid = __builtin_amdgcn_readfirstlane(tid >> 6), lane = tid & 63, wr = wid >> 2, wc = wid & 3, fr = lane & 15, fq = lane >> 4;
    const int K = g.K, nt = K / BK;
    unsigned voffA[2], voffB[2];
#pragma unroll
    for (int i = 0; i < 2; ++i) { int R, C; stage_rc(tid * 16 + i * 8192, R, C); const int Rb = Epi::PERM ? ((R & ~31) + perm32(R & 31)) : R;
        voffA[i] = (unsigned)(R * K + C) * 2u; voffB[i] = (unsigned)(Rb * K + C) * 2u; }
    const size_t kstep = (size_t)(BK * 2);
    const size_t hstep = (size_t)HALF * K * 2;
    const size_t tstep = 2 * hstep;
    const unsigned ldsw = (unsigned)wid * 1024u;
    const int aoff = lds_byte(wr * 64 + fr, fq * 8), boff = lds_byte(wc * 32 + fr, fq * 8);
#define PG8_SA(b, h) (((b) * 2 + (h)) * HTB)
#define PG8_SB(b, h) ((4 + (b) * 2 + (h)) * HTB)
#define PG8_STAGE(bufoff, gbase, voff) do { _Pragma("unroll") for (int _i = 0; _i < 2; ++_i) \
        __builtin_amdgcn_global_load_lds((const unsigned*)((const char*)(gbase) + (voff)[_i]), (PG8_LAS unsigned*)(lds + (bufoff) + ldsw + _i * 8192), 16, 0, 0); } while (0)
#define PG8_LDA(dst, b, h) do { _Pragma("unroll") for (int m = 0; m < 4; ++m) _Pragma("unroll") for (int k = 0; k < 2; ++k) dst[m][k] = *(const PG8_LAS bf16x8*)(lds + PG8_SA(b, h) + aoff + m * 2048 + k * 1024); } while (0)
#define PG8_LDB(dst, b, h) do { _Pragma("unroll") for (int n = 0; n < 2; ++n) _Pragma("unroll") for (int k = 0; k < 2; ++k) dst[n][k] = *(const PG8_LAS bf16x8*)(lds + PG8_SB(b, h) + boff + n * 2048 + k * 1024); } while (0)
#define PG8_MMA(ai, bj, At, Bt) do { __builtin_amdgcn_s_setprio(1); _Pragma("unroll") for (int m = 0; m < 4; ++m) _Pragma("unroll") for (int n = 0; n < 2; ++n) _Pragma("unroll") for (int k = 0; k < 2; ++k) \
        acc[ai][bj][m][n] = __builtin_amdgcn_mfma_f32_16x16x32_bf16(Bt[n][k], At[m][k], acc[ai][bj][m][n], 0, 0, 0); __builtin_amdgcn_s_setprio(0); } while (0)
#define PG8_WAIT_V(n) asm volatile("s_waitcnt vmcnt(" #n ")" ::: "memory")
#define PG8_WAIT_L(n) asm volatile("s_waitcnt lgkmcnt(" #n ")" ::: "memory")
#define PG8_BAR __builtin_amdgcn_s_barrier()
#define PG8_SCHED __builtin_amdgcn_sched_barrier(0)
    Unit cur, nxt; int ui = 0;
    if (!S.next(0, cur)) return;
    f32x4 acc[2][2][4][2];
#pragma unroll
    for (int a = 0; a < 2; ++a)
#pragma unroll
        for (int b = 0; b < 2; ++b)
#pragma unroll
            for (int m = 0; m < 4; ++m)
#pragma unroll
                for (int n = 0; n < 2; ++n) acc[a][b][m][n] = (f32x4){0.f, 0.f, 0.f, 0.f};
    bf16x8 At[4][2], B0[2][2], B1[2][2];
    const char* cA = (const char*)g.A + (size_t)cur.pm * tstep; const char* cB = (const char*)g.Bt + (size_t)cur.pn * tstep;
    S.a_ready(cur);
    if constexpr (SP2) {
        PG8_STAGE(PG8_SB(0, 0), cB, voffB); PG8_STAGE(PG8_SB(0, 1), cB + hstep, voffB); PG8_STAGE(PG8_SA(0, 0), cA, voffA); PG8_STAGE(PG8_SA(0, 1), cA + hstep, voffA);
        if (wr == 1) PG8_BAR;
        PG8_WAIT_V(2); PG8_BAR;
        PG8_STAGE(PG8_SB(1, 0), cB + kstep, voffB); PG8_STAGE(PG8_SA(1, 0), cA + kstep, voffA); PG8_STAGE(PG8_SB(1, 1), cB + hstep + kstep, voffB);
        PG8_WAIT_V(6); PG8_BAR;
    } else {
        PG8_STAGE(PG8_SB(0, 0), cB, voffB); PG8_STAGE(PG8_SA(0, 0), cA, voffA); PG8_STAGE(PG8_SB(0, 1), cB + hstep, voffB); PG8_STAGE(PG8_SA(0, 1), cA + hstep, voffA);
        if (wr == 1) PG8_BAR;
        PG8_WAIT_V(4); PG8_BAR;
        PG8_STAGE(PG8_SB(1, 0), cB + kstep, voffB); PG8_STAGE(PG8_SA(1, 0), cA + kstep, voffA); PG8_STAGE(PG8_SB(1, 1), cB + hstep + kstep, voffB);
        PG8_WAIT_V(6); PG8_BAR;
    }
    for (;;) {
        const bool has_next = S.next(ui + 1, nxt);
        const char* nA = has_next ? (const char*)g.A + (size_t)nxt.pm * tstep : cA; const char* nB = has_next ? (const char*)g.Bt + (size_t)nxt.pn * tstep : cB;
        for (int t = 0; t < nt; t += 2) {
            const bool last = (t == nt - 2);
            const char* a1 = cA + (size_t)(t + 1) * kstep;
            const char* a2 = last ? nA : cA + (size_t)(t + 2) * kstep; const char* b2 = last ? nB : cB + (size_t)(t + 2) * kstep;
            const char* a3 = a2 + kstep; const char* b3 = b2 + kstep;
            if (last && has_next) S.a_ready(nxt);
            if constexpr (SP2) {
            PG8_LDB(B0, 0, 0); PG8_LDB(B1, 0, 1); PG8_SCHED; PG8_LDA(At, 0, 0); PG8_STAGE(PG8_SA(1, 1), a1 + hstep, voffA);
            PG8_WAIT_V(8); PG8_WAIT_L(0); PG8_BAR; PG8_MMA(0, 0, At, B0); PG8_MMA(0, 1, At, B1); PG8_BAR; PG8_SCHED;
            PG8_LDA(At, 0, 1); PG8_STAGE(PG8_SB(0, 0), b2, voffB); PG8_STAGE(PG8_SB(0, 1), b2 + hstep, voffB); PG8_STAGE(PG8_SA(0, 0), a2, voffA);
            PG8_WAIT_V(8); PG8_WAIT_L(0); PG8_BAR; PG8_MMA(1, 0, At, B0); PG8_MMA(1, 1, At, B1); PG8_BAR; PG8_SCHED;
            PG8_LDB(B0, 1, 0); PG8_LDB(B1, 1, 1); PG8_SCHED; PG8_LDA(At, 1, 0); PG8_STAGE(PG8_SA(0, 1), a2 + hstep, voffA);
            PG8_WAIT_V(8); PG8_WAIT_L(0); PG8_BAR; PG8_MMA(0, 0, At, B0); PG8_MMA(0, 1, At, B1); PG8_BAR; PG8_SCHED;
            PG8_LDA(At, 1, 1); PG8_STAGE(PG8_SB(1, 0), b3, voffB); PG8_STAGE(PG8_SB(1, 1), b3 + hstep, voffB); PG8_STAGE(PG8_SA(1, 0), a3, voffA);
            PG8_WAIT_V(8); PG8_WAIT_L(0); PG8_BAR; PG8_MMA(1, 0, At, B0); PG8_MMA(1, 1, At, B1); PG8_BAR; PG8_SCHED;
            } else {
            PG8_LDB(B0, 0, 0); PG8_SCHED; PG8_LDA(At, 0, 0); PG8_STAGE(PG8_SA(1, 1), a1 + hstep, voffA);
            PG8_WAIT_L(8); PG8_BAR; PG8_WAIT_L(0); PG8_MMA(0, 0, At, B0); PG8_BAR; PG8_SCHED;
            PG8_LDB(B1, 0, 1); PG8_STAGE(PG8_SB(0, 0), b2, voffB);
            PG8_BAR; PG8_WAIT_L(0); PG8_MMA(0, 1, At, B1); PG8_BAR;
            PG8_LDA(At, 0, 1); PG8_STAGE(PG8_SA(0, 0), a2, voffA);
            PG8_BAR; PG8_WAIT_L(0); PG8_MMA(1, 0, At, B0); PG8_BAR; PG8_SCHED;
            PG8_STAGE(PG8_SB(0, 1), b2 + hstep, voffB);
            PG8_WAIT_V(6); PG8_BAR; PG8_MMA(1, 1, At, B1); PG8_BAR;
            PG8_LDB(B0, 1, 0); PG8_SCHED; PG8_LDA(At, 1, 0); PG8_STAGE(PG8_SA(0, 1), a2 + hstep, voffA);
            PG8_WAIT_L(8); PG8_BAR; PG8_WAIT_L(0); PG8_MMA(0, 0, At, B0); PG8_BAR; PG8_SCHED;
            PG8_LDB(B1, 1, 1); PG8_STAGE(PG8_SB(1, 0), b3, voffB);
            PG8_BAR; PG8_WAIT_L(0); PG8_MMA(0, 1, At, B1); PG8_BAR;
            PG8_LDA(At, 1, 1); PG8_STAGE(PG8_SA(1, 0), a3, voffA);
            PG8_BAR; PG8_WAIT_L(0); PG8_MMA(1, 0, At, B0); PG8_BAR; PG8_SCHED;
            PG8_STAGE(PG8_SB(1, 1), b3 + hstep, voffB);
            PG8_WAIT_V(6); PG8_BAR; PG8_MMA(1, 1, At, B1); PG8_BAR;
            }
        }
        if constexpr (ALIGN_EPI) { if (wr == 0) PG8_BAR; }
        if constexpr (!Epi::AFTER_DRAIN) { E(acc, cur, wr, wc, fr, fq); S.done(cur); }
        if (!has_next) break;
#pragma unroll
        for (int a = 0; a < 2; ++a)
#pragma unroll
            for (int b = 0; b < 2; ++b)
#pragma unroll
                for (int m = 0; m < 4; ++m)
#pragma unroll
                    for (int n = 0; n < 2; ++n) acc[a][b][m][n] = (f32x4){0.f, 0.f, 0.f, 0.f};
        cur = nxt; cA = nA; cB = nB; ++ui;
        if constexpr (ALIGN_EPI) { if (wr == 1) PG8_BAR; }
    }
    PG8_WAIT_V(0);
    if constexpr (!ALIGN_EPI) { if (wr == 0) PG8_BAR; }
    PG8_BAR;
    if constexpr (Epi::AFTER_DRAIN) { E.fused(acc, cur, wr, wc, fr, fq, lds, wid, lane); S.done(cur); }
#undef PG8_SA
#undef PG8_SB
#undef PG8_STAGE
#undef PG8_LDA
#undef PG8_LDB
#undef PG8_MMA
#undef PG8_WAIT_V
#undef PG8_WAIT_L
#undef PG8_BAR
#undef PG8_SCHED
}
}

struct Frame {
    LAS unsigned char* lds;
    volatile LAS unsigned* MISC;
    gu32* ctl;
    int tid, lane, wave, vcu, G;
    const float *x, *norm_w, *w_in, *w_gate_up, *b_gate, *lq1, *lk1, *lq2, *lk2, *subln_w, *gla_w, *w_out, *fin_w;
    float* out;
    bf16 *Win_t, *Wout_t, *XN, *Y, *QA, *KA, *VA, *SGA, *QB, *KB, *VB, *SGB;
    float *Gg, *O1, *GST;
};
__device__ __forceinline__ float wave_sum(float v) {
#pragma unroll
    for (int o = 1; o < 64; o <<= 1) v += __shfl_xor(v, o);
    return v;
}

__device__ __forceinline__ void p0_transpose_item(const float* W, int K, int ldw, int nblk, const float* ks, bf16* WT, int row_off, LAS float* scr, int item, int lane) {
    const int kb = item / nblk, nb = item % nblk, k0 = 64 * kb, n0 = 32 * nb;
#pragma unroll 8
    for (int i = 0; i < 32; ++i) { const int kk = 2 * i + (lane >> 5); float v = W[(size_t)(k0 + kk) * ldw + n0 + (lane & 31)]; if (ks) v *= ks[k0 + kk]; scr[kk * 33 + (lane & 31)] = v; }
    LDS_WAIT(); asm volatile("" ::: "memory");
    const int c = lane & 7;
#pragma unroll
    for (int j = 0; j < 4; ++j) { const int n = (lane >> 3) + 8 * j; const LAS float* s = scr + (8 * c) * 33 + n;
        v4u o; o.x = pk2(s[0 * 33], s[1 * 33]); o.y = pk2(s[2 * 33], s[3 * 33]); o.z = pk2(s[4 * 33], s[5 * 33]); o.w = pk2(s[6 * 33], s[7 * 33]);
        *(GAS v4u*)(WT + (size_t)(row_off + n0 + n) * K + k0 + 8 * c) = o; }
    LDS_WAIT(); asm volatile("" ::: "memory");
}
__device__ __forceinline__ void rms_row_to_bf16(Frame& F, const float* xrow, bf16* orow) {
    const GAS f32x4* xr = (const GAS f32x4*)xrow + F.lane;
    f32x4 v[4]; float s = 0.f;
#pragma unroll
    for (int j = 0; j < 4; ++j) { v[j] = xr[64 * j]; s += (v[j].x * v[j].x + v[j].y * v[j].y) + (v[j].z * v[j].z + v[j].w * v[j].w); }
    const float rstd = 1.f / sqrtf(wave_sum(s) * (1.f / D) + EPS);
    GAS unsigned long long* o8 = (GAS unsigned long long*)orow + F.lane;
#pragma unroll
    for (int j = 0; j < 4; ++j) o8[64 * j] = (unsigned long long)pk2(v[j].x * rstd, v[j].y * rstd) | ((unsigned long long)pk2(v[j].z * rstd, v[j].w * rstd) << 32);
}
__device__ __forceinline__ void p0_prologue(Frame& F) {
    LAS float* scr = (LAS float*)(F.lds + F.wave * 16384);
    const int gw = F.vcu * NWAVES + F.wave, NGW = F.G * NWAVES;
    constexpr int I_IN = (D / 64) * (3584 / 32), I_OUT = (D / 64) * (D / 32);
    for (int it = gw; it < I_IN + I_OUT; it += NGW) {
        if (it < I_IN) p0_transpose_item(F.w_in, D, IN_COLS, 3584 / 32, F.norm_w, F.Win_t, 0, scr, it, F.lane);
        else p0_transpose_item(F.w_out, D, D, D / 32, nullptr, F.Wout_t, 0, scr, it - I_IN, F.lane);
    }
    const int gt = (F.vcu * NWAVES + F.wave) * 64 + F.lane, NGT = NGW * 64;
    for (int it = gt; it < 256 * (D / 8); it += NGT) {
        const int j = it / (D / 8), k0 = (it % (D / 8)) * 8;
        float wg[16];
#pragma unroll
        for (int r = 0; r < 16; ++r) wg[r] = F.w_gate_up[r * 256 + j];
        float o[8];
#pragma unroll
        for (int i = 0; i < 8; ++i) { const float* wr = F.w_in + (size_t)(k0 + i) * IN_COLS + 3584; float a = 0.f;
#pragma unroll
            for (int r = 0; r < 16; ++r) a += wr[r] * wg[r];
            o[i] = a * F.norm_w[k0 + i]; }
        v4u w; w.x = pk2(o[0], o[1]); w.y = pk2(o[2], o[3]); w.z = pk2(o[4], o[5]); w.w = pk2(o[6], o[7]);
        *(GAS v4u*)(F.Win_t + (size_t)(3584 + j) * D + k0) = w;
    }
    for (int m = gw; m < M; m += NGW) rms_row_to_bf16(F, F.x + (size_t)m * D, F.XN + (size_t)m * D);
}

__device__ __forceinline__ float lambda_full(Frame& F) {
    float s1 = 0.f, s2 = 0.f;
    for (int i = 0; i < 64; ++i) { s1 += F.lq1[i] * F.lk1[i]; s2 += F.lq2[i] * F.lk2[i]; }
    return __expf(s1) - __expf(s2) + LAM_INIT;
}
__device__ __forceinline__ void simple_attn(Frame& F) {
    LAS float* Ks = (LAS float*)F.lds;
    LAS float* Vs = Ks + 64 * 64;
    const int tid = F.tid;
    const float lam = lambda_full(F);
    for (int u = blockIdx.x; u < 256; u += gridDim.x) {
        const int b = u >> 5, h = (u >> 3) & 3, p = u & 7;
        const float slope2 = exp2f(-2.f * (float)(h + 1)) * LOG2E;
        for (int half = 0; half < 2; ++half) {
            const int rb = half ? 15 - p : p;
            const int row = rb * 512 + tid;
            const size_t grow = (size_t)b * T + row;
            const int ntiles = (rb * 512 + 512) / 64;
            float ssq = 0.f;
            float* o1 = F.O1 + grow * 512 + h * 128;
            for (int pass = 0; pass < 4; ++pass) {
                const int sub = pass >> 1, eh = pass & 1;
                unsigned qw[32];
                { const GAS v4u* qp = (const GAS v4u*)(F.QA + grow * 512 + h * 128 + sub * 64);
#pragma unroll
                  for (int i = 0; i < 8; ++i) { const v4u w = qp[i]; qw[4 * i] = w.x; qw[4 * i + 1] = w.y; qw[4 * i + 2] = w.z; qw[4 * i + 3] = w.w; } }
                float mx = -1e30f, l = 0.f; float o[64];
#pragma unroll
                for (int e = 0; e < 64; ++e) o[e] = 0.f;
                for (int kt = 0; kt < ntiles; ++kt) {
                    __syncthreads();
                    { const int key = tid >> 3, seg = (tid & 7) * 8; const size_t kr = (size_t)b * T + kt * 64 + key;
                      const v4u w = *(const GAS v4u*)(F.KA + kr * 512 + h * 128 + sub * 64 + seg);
                      LAS float* d = Ks + key * 64 + seg; d[0] = bflo(w.x); d[1] = bfhi(w.x); d[2] = bflo(w.y); d[3] = bfhi(w.y); d[4] = bflo(w.z); d[5] = bfhi(w.z); d[6] = bflo(w.w); d[7] = bfhi(w.w);
                      const v4u x = *(const GAS v4u*)(F.VA + kr * 512 + h * 128 + eh * 64 + seg);
                      LAS float* e = Vs + key * 64 + seg; e[0] = bflo(x.x); e[1] = bfhi(x.x); e[2] = bflo(x.y); e[3] = bfhi(x.y); e[4] = bflo(x.z); e[5] = bfhi(x.z); e[6] = bflo(x.w); e[7] = bfhi(x.w); }
                    __syncthreads();
                    const int jn = row - kt * 64;
                    for (int j = 0; j < 64; ++j) {
                        if (j > jn) break;
                        float s = 0.f;
#pragma unroll
                        for (int dd = 0; dd < 32; ++dd) { s += bflo(qw[dd]) * Ks[j * 64 + 2 * dd]; s += bfhi(qw[dd]) * Ks[j * 64 + 2 * dd + 1]; }
                        s -= slope2 * (float)(jn - j);
                        if (s > mx) { const float al = exp2f(mx - s); l *= al;
#pragma unroll
                            for (int e = 0; e < 64; ++e) o[e] *= al;
                            mx = s; }
                        const float pp = exp2f(s - mx); l += pp;
#pragma unroll
                        for (int e = 0; e < 64; ++e) o[e] += pp * Vs[j * 64 + e];
                    }
                }
                const float rl = 1.f / l;
                if (sub == 0) {
#pragma unroll
                    for (int e = 0; e < 64; e += 4) *(GAS f32x4*)(o1 + eh * 64 + e) = (f32x4){o[e] * rl, o[e + 1] * rl, o[e + 2] * rl, o[e + 3] * rl};
                } else {
#pragma unroll
                    for (int e = 0; e < 64; e += 4) { const f32x4 a = *(const GAS f32x4*)(o1 + eh * 64 + e);
                        const f32x4 dv = (f32x4){a.x - lam * o[e] * rl, a.y - lam * o[e + 1] * rl, a.z - lam * o[e + 2] * rl, a.w - lam * o[e + 3] * rl};
                        ssq += (dv.x * dv.x + dv.y * dv.y) + (dv.z * dv.z + dv.w * dv.w);
                        *(GAS f32x4*)(o1 + eh * 64 + e) = dv; }
                }
            }
            {
                const float rstd = (1.f - LAM_INIT) / sqrtf(ssq * (1.f / 128.f) + EPS);
                const bf16* sg = F.SGA + grow * 512 + h * 128; bf16* y = F.Y + grow * 1024 + h * 128;
                for (int e = 0; e < 128; e += 8) { const v4u g = *(const GAS v4u*)(sg + e); const f32x4 a0 = *(const GAS f32x4*)(o1 + e), a1 = *(const GAS f32x4*)(o1 + e + 4); v4u w;
                    w.x = pk2(a0.x * rstd * F.subln_w[e] * bflo(g.x), a0.y * rstd * F.subln_w[e + 1] * bfhi(g.x));
                    w.y = pk2(a0.z * rstd * F.subln_w[e + 2] * bflo(g.y), a0.w * rstd * F.subln_w[e + 3] * bfhi(g.y));
                    w.z = pk2(a1.x * rstd * F.subln_w[e + 4] * bflo(g.z), a1.y * rstd * F.subln_w[e + 5] * bfhi(g.z));
                    w.w = pk2(a1.z * rstd * F.subln_w[e + 6] * bflo(g.w), a1.w * rstd * F.subln_w[e + 7] * bfhi(g.w));
                    *(GAS v4u*)(y + e) = w; }
            }
        }
    }
    __syncthreads();
}

namespace da {
typedef short bf16x8 __attribute__((ext_vector_type(8)));
typedef short s16x4 __attribute__((ext_vector_type(4)));
typedef float f32x16 __attribute__((ext_vector_type(16)));
typedef unsigned u32x4 __attribute__((ext_vector_type(4)));
constexpr int NW = 8, QBLK = 32, KVBLK = 64, QB = NW * QBLK;
constexpr int SHM_V = KVBLK * 128 * 2, SHM_K = KVBLK * 64 * 2;
constexpr int ATT_LDS = 2 * SHM_V + 2 * SHM_K + NW * 64 * 4;
constexpr int PQ = 512, PK = 512, PV = 512;
constexpr float THR2 = 8.f;
#define DA_KSWZ(row, colB) ((row) * 128 + ((colB) ^ ((((row) >> 1) & 7) << 4)))
#define DA_SBAR() __builtin_amdgcn_sched_barrier(0)
__device__ __forceinline__ int v_st(int k, int c) { const int kk = (k & ~0xC) | ((k & 4) << 1) | ((k & 8) >> 1); return ((kk >> 3) * 4 + (c >> 5)) * 512 + ((kk & 7) * 32 + (c & 31)) * 2; }
__device__ __forceinline__ int v_rd_base(int lane) { return ((lane & 3) << 3) | (((lane >> 2) & 3) << 6) | (((lane >> 4) & 1) << 5) | (((lane >> 5) & 1) << 8); }
constexpr int v_rd_off(int d0, int ks, int half) { return d0 * 512 + ks * 4096 + half * 2048; }
__device__ __forceinline__ int crow(int r, int hi) { return (r & 3) + 8 * (r >> 2) + 4 * hi; }
__device__ __forceinline__ unsigned cvtpk(float lo, float hi) { unsigned r; asm volatile("v_cvt_pk_bf16_f32 %0, %1, %2" : "=v"(r) : "v"(lo), "v"(hi)); return r; }
__device__ __forceinline__ void mask_tile(f32x16& p0, f32x16& p1, int dq) {
    const float NEG = -__builtin_inff();
#pragma unroll
    for (int r = 0; r < 16; ++r) { const int c = (r & 3) + 8 * (r >> 2); if (c > dq) p0[r] = NEG; if (c + 32 > dq) p1[r] = NEG; }
}
__device__ __forceinline__ void partialSM(f32x16& p0, f32x16& p1, float& m_reg, float& alpha) {
    float pmax = p0[0];
#pragma unroll
    for (int r = 1; r < 16; ++r) pmax = fmaxf(pmax, p0[r]);
#pragma unroll
    for (int r = 0; r < 16; ++r) pmax = fmaxf(pmax, p1[r]);
    { auto rr = __builtin_amdgcn_permlane32_swap(__float_as_uint(pmax), __float_as_uint(pmax), false, false);
      pmax = fmaxf(__uint_as_float(rr[0]), __uint_as_float(rr[1])); }
    float mn;
    if (__builtin_expect(__all(pmax - m_reg <= THR2), 1)) { mn = m_reg; alpha = 1.f; }
    else { mn = fmaxf(m_reg, pmax); alpha = __builtin_amdgcn_exp2f(m_reg - mn); m_reg = mn; }
#pragma unroll
    for (int r = 0; r < 16; ++r) { p0[r] -= mn; p1[r] -= mn; }
#pragma unroll
    for (int r = 0; r < 16; ++r) p0[r] = __builtin_amdgcn_exp2f(p0[r]);
}
__device__ __forceinline__ void finishSM(f32x16& p0, f32x16& p1, float alpha, float& l_reg, bf16x8& pa0, bf16x8& pa1, bf16x8& pa2, bf16x8& pa3) {
#pragma unroll
    for (int r = 0; r < 16; ++r) p1[r] = __builtin_amdgcn_exp2f(p1[r]);
    float ps = 0;
#pragma unroll
    for (int r = 0; r < 16; ++r) ps += p0[r];
#pragma unroll
    for (int r = 0; r < 16; ++r) ps += p1[r];
    { auto rr = __builtin_amdgcn_permlane32_swap(__float_as_uint(ps), __float_as_uint(ps), false, false);
      ps = __uint_as_float(rr[0]) + __uint_as_float(rr[1]); }
    l_reg = l_reg * alpha + ps;
#define DA_PK4(P, B_, OUT) do { unsigned a0 = cvtpk(P[B_+0], P[B_+1]), a1 = cvtpk(P[B_+2], P[B_+3]);                          \
        unsigned b0 = cvtpk(P[B_+4], P[B_+5]), b1 = cvtpk(P[B_+6], P[B_+7]);                                             \
        auto r0 = __builtin_amdgcn_permlane32_swap(a0, b0, false, false); auto r1 = __builtin_amdgcn_permlane32_swap(a1, b1, false, false); \
        u32x4 w = {r0[0], r1[0], r0[1], r1[1]}; OUT = *reinterpret_cast<bf16x8*>(&w); } while (0)
    DA_PK4(p0, 0, pa0); DA_PK4(p0, 8, pa1); DA_PK4(p1, 0, pa2); DA_PK4(p1, 8, pa3);
#undef DA_PK4
}
template <int KB>
__device__ __forceinline__ void qkt(f32x16& p0, f32x16& p1, const char* K_lds, int r32, int hi, const bf16x8* qr, float bias0, float slope2) {
#pragma unroll
    for (int r = 0; r < 16; ++r) { const float c = (float)((r & 3) + 8 * (r >> 2)); p0[r] = fmaf(slope2, c, bias0); p1[r] = fmaf(slope2, c + 32.f, bias0); }
    const char* kb[4];
#pragma unroll
    for (int dd = 0; dd < 4; ++dd) kb[dd] = K_lds + KB * SHM_K + DA_KSWZ(r32, (dd * 16 + hi * 8) * 2);
#pragma unroll
    for (int d0 = 0; d0 < 4; ++d0) {
        bf16x8 b0 = *reinterpret_cast<const bf16x8*>(kb[d0]);
        bf16x8 b1 = *reinterpret_cast<const bf16x8*>(kb[d0] + 32 * 128);
        p0 = __builtin_amdgcn_mfma_f32_32x32x16_bf16(b0, qr[d0], p0, 0, 0, 0);
        p1 = __builtin_amdgcn_mfma_f32_32x32x16_bf16(b1, qr[d0], p1, 0, 0, 0); }
}
template <int VB>
__device__ __forceinline__ void pv_tile(f32x16* o, int vb0, bf16x8 pa0, bf16x8 pa1, bf16x8 pa2, bf16x8 pa3) {
#define DA_TRRD(dst, off) asm volatile("ds_read_b64_tr_b16 %0, %1 offset:%2" : "=&v"(dst) : "v"(vb0), "i"(off) : "memory")
#define DA_PV_D0(d0) do { s16x4 l0, l1, l2, l3, h0, h1, h2, h3; constexpr int b_ = VB * SHM_V + v_rd_off(d0, 0, 0); \
        DA_TRRD(l0, b_); DA_TRRD(h0, b_ + 2048); DA_TRRD(l1, b_ + 4096); DA_TRRD(h1, b_ + 6144); DA_TRRD(l2, b_ + 8192); DA_TRRD(h2, b_ + 10240); DA_TRRD(l3, b_ + 12288); DA_TRRD(h3, b_ + 14336); \
        asm volatile("s_waitcnt lgkmcnt(0)" ::: "memory"); DA_SBAR();   \
        o[d0] = __builtin_amdgcn_mfma_f32_32x32x16_bf16(pa0, (bf16x8){l0[0], l0[1], l0[2], l0[3], h0[0], h0[1], h0[2], h0[3]}, o[d0], 0, 0, 0);   \
        o[d0] = __builtin_amdgcn_mfma_f32_32x32x16_bf16(pa1, (bf16x8){l1[0], l1[1], l1[2], l1[3], h1[0], h1[1], h1[2], h1[3]}, o[d0], 0, 0, 0);   \
        o[d0] = __builtin_amdgcn_mfma_f32_32x32x16_bf16(pa2, (bf16x8){l2[0], l2[1], l2[2], l2[3], h2[0], h2[1], h2[2], h2[3]}, o[d0], 0, 0, 0);   \
        o[d0] = __builtin_amdgcn_mfma_f32_32x32x16_bf16(pa3, (bf16x8){l3[0], l3[1], l3[2], l3[3], h3[0], h3[1], h3[2], h3[3]}, o[d0], 0, 0, 0); } while (0)
    DA_PV_D0(0); DA_PV_D0(1); DA_PV_D0(2); DA_PV_D0(3);
#undef DA_PV_D0
#undef DA_TRRD
}
struct BlockRef { const bf16* Q; const bf16* K; const bf16* V; float* O1; bf16* Y; const bf16* SG; int P0; int sub; float slope2; int jlo; };
struct Seam { bf16x8 qr[4]; bf16x8 st_v0, st_v1, st_k0; };
struct Consts { float lam; const float* subln_w; };
#define DA_VMW() asm volatile("s_waitcnt vmcnt(0)" ::: "memory")
#define DA_VMWN(n) asm volatile("s_waitcnt vmcnt(%0)" :: "i"(n) : "memory")
#define DA_SLOAD(Kp, Vp, k0) do { S.st_v0 = *reinterpret_cast<const bf16x8*>((Vp) + (size_t)((k0) + sr) * PV + sc); S.st_v1 = *reinterpret_cast<const bf16x8*>((Vp) + (size_t)((k0) + 32 + sr) * PV + sc); \
                                  S.st_k0 = *reinterpret_cast<const bf16x8*>((Kp) + (size_t)((k0) + ksr) * PK + ksc); } while (0)
#define DA_SWRITE_K(bf) do { *(bf16x8*)(K_lds + (bf) * SHM_K + kws) = S.st_k0; } while (0)
#define DA_SWRITE_V(bf) do { *(bf16x8*)(V_lds + (bf) * SHM_V + vst0) = S.st_v0; *(bf16x8*)(V_lds + (bf) * SHM_V + vst1) = S.st_v1; } while (0)
__device__ __forceinline__ void prime(const BlockRef& cur, char* lds, Seam& S) {
    const int tid = threadIdx.x, wid = __builtin_amdgcn_readfirstlane(tid >> 6), lane = tid & 63, r32 = lane & 31, hi = lane >> 5;
    const int sr = tid >> 4, sc = (tid & 15) * 8, ksr = tid >> 3, ksc = (tid & 7) * 8, kws = DA_KSWZ(ksr, ksc * 2); char* K_lds = lds + 2 * SHM_V;
    const int kb0 = cur.jlo * KVBLK;
#pragma unroll
    for (int d0 = 0; d0 < 4; ++d0) S.qr[d0] = *reinterpret_cast<const bf16x8*>(cur.Q + (size_t)(wid * QBLK + r32) * PQ + d0 * 16 + hi * 8);
    DA_SLOAD(cur.K, cur.V, kb0); DA_VMW(); DA_SWRITE_K(0);
    __syncthreads();
}
__device__ __forceinline__ void block(const BlockRef& cur, const BlockRef& nxt, char* lds, Seam& S, const Consts& C) {
    const int tid = threadIdx.x, wid = __builtin_amdgcn_readfirstlane(tid >> 6), lane = tid & 63, r32 = lane & 31, hi = lane >> 5;
    const int j_lo = cur.jlo, j_hi = (cur.P0 + QB - 1) / KVBLK + 1;
    const int NT = j_hi - j_lo;
    const int kbn = nxt.jlo * KVBLK;
    const int qlo = cur.P0 + wid * QBLK, qm = qlo + r32 - 4 * hi;
    char* V_lds = lds; char* K_lds = lds + 2 * SHM_V;
    float* ws = (float*)(lds + 2 * SHM_V + 2 * SHM_K) + wid * 64; float* li_l = ws, * al_l = ws + 32;
    float m_reg = -1e30f, l_reg = 0; f32x16 o[4] = {};
    const int sr = tid >> 4, sc = (tid & 15) * 8, vst0 = v_st(sr, sc), vst1 = v_st(32 + sr, sc), ksr = tid >> 3, ksc = (tid & 7) * 8, kws = DA_KSWZ(ksr, ksc * 2);
    const int vb0 = (int)(uintptr_t)V_lds + v_rd_base(lane);
    const bf16* Kh = cur.K; const bf16* Vh = cur.V;
    const float slope2 = cur.slope2;
#define DA_RESC(a) do { if (__any((a) < 1.f)) { if (hi == 0) al_l[r32] = (a); asm volatile("s_waitcnt lgkmcnt(0)" ::: "memory");              \
                     for (int d_ = 0; d_ < 4; ++d_) for (int r = 0; r < 16; ++r) o[d_][r] *= al_l[crow(r, hi)]; } } while (0)
#define DA_KBASE(t) ((j_lo + (t)) * KVBLK)
#define DA_BIAS(t) (slope2 * (float)(DA_KBASE(t) - cur.P0 + 4 * hi))
#define DA_MASKT(P0_, P1_, t) do { const int kb_ = DA_KBASE(t); if (kb_ + KVBLK - 1 > qlo) mask_tile(P0_, P1_, qm - kb_); } while (0)
    f32x16 pA0, pA1, pB0, pB1; float alA, alB; bf16x8 pa0, pa1, pa2, pa3;
    DA_SWRITE_V(0); DA_SBAR();
    if (NT > 1) DA_SLOAD(Kh, Vh, DA_KBASE(1));
    DA_SBAR(); qkt<0>(pA0, pA1, K_lds, r32, hi, S.qr, DA_BIAS(0), slope2);
    DA_MASKT(pA0, pA1, 0); partialSM(pA0, pA1, m_reg, alA);
    if (NT > 1) { DA_VMW(); DA_SWRITE_V(1); DA_SWRITE_K(1); }
    __syncthreads();
#define DA_HALF_STEP(PX0, PX1, alX, PY0, PY1, alY, t, KB, VB, SB) do {                                         \
        DA_SBAR(); qkt<KB>(PX0, PX1, K_lds, r32, hi, S.qr, DA_BIAS(t), slope2);                                  \
        finishSM(PY0, PY1, alY, l_reg, pa0, pa1, pa2, pa3); DA_SBAR();                                           \
        if ((t) + 1 < NT) { DA_SLOAD(Kh, Vh, DA_KBASE((t) + 1)); DA_SBAR(); }                                    \
        pv_tile<VB>(o, vb0, pa0, pa1, pa2, pa3); DA_MASKT(PX0, PX1, (t)); partialSM(PX0, PX1, m_reg, alX);       \
        __syncthreads();                                                                                         \
        if ((t) + 1 < NT) { DA_VMW(); DA_SWRITE_V(SB); DA_SWRITE_K(SB); }                                        \
        DA_RESC(alX); __syncthreads(); } while (0)
    for (int t = 1; t + 1 < NT; t += 2) {
        DA_HALF_STEP(pB0, pB1, alB, pA0, pA1, alA, t, 1, 0, 0);
        DA_HALF_STEP(pA0, pA1, alA, pB0, pB1, alB, t + 1, 0, 1, 1);
    }
    const bool even = (NT & 1) == 0;
    if (even) { DA_SBAR(); qkt<1>(pB0, pB1, K_lds, r32, hi, S.qr, DA_BIAS(NT - 1), slope2); DA_SBAR(); }
    DA_SLOAD(nxt.K, nxt.V, kbn); DA_SBAR();
#pragma unroll
    for (int d0 = 0; d0 < 4; ++d0) S.qr[d0] = *reinterpret_cast<const bf16x8*>(nxt.Q + (size_t)(wid * QBLK + r32) * PQ + d0 * 16 + hi * 8);
    DA_SBAR();
    finishSM(pA0, pA1, alA, l_reg, pa0, pa1, pa2, pa3); DA_SBAR();
    pv_tile<0>(o, vb0, pa0, pa1, pa2, pa3);
    if (even) { DA_MASKT(pB0, pB1, NT - 1); partialSM(pB0, pB1, m_reg, alB); __syncthreads(); DA_RESC(alB);
        finishSM(pB0, pB1, alB, l_reg, pa0, pa1, pa2, pa3); DA_SBAR(); pv_tile<1>(o, vb0, pa0, pa1, pa2, pa3); }
    DA_SBAR(); DA_VMWN(4); DA_SWRITE_K(0); DA_SBAR();
    if (hi == 0) li_l[r32] = l_reg; asm volatile("s_waitcnt lgkmcnt(0)" ::: "memory");
    float rli[16];
#pragma unroll
    for (int r = 0; r < 16; ++r) rli[r] = __builtin_amdgcn_rcpf(li_l[crow(r, hi)]);
    float* stg = (float*)(lds + ATT_LDS) + wid * 2048;
    int srow = lane >> 4, scol = (lane & 15) * 4;
    asm volatile("" : "+v"(srow), "+v"(scol));
    typedef float f32x4e __attribute__((ext_vector_type(4)));
    typedef unsigned u32x2e __attribute__((ext_vector_type(2)));
    float* gO = cur.O1 + (size_t)(wid * QBLK + srow) * 512 + scol;
    if (cur.sub == 0) {
#pragma unroll
        for (int hf = 0; hf < 2; ++hf) {
#pragma unroll
            for (int r = 0; r < 16; ++r)
#pragma unroll
                for (int dd = 0; dd < 2; ++dd) stg[crow(r, hi) * 64 + dd * 32 + r32] = o[2 * hf + dd][r] * rli[r];
            asm volatile("s_waitcnt lgkmcnt(0)" ::: "memory");
#pragma unroll
            for (int i = 0; i < 8; ++i) { const f32x4e v = *(const f32x4e*)(stg + (i * 4 + srow) * 64 + scol); *(f32x4e*)(gO + (size_t)i * 4 * 512 + hf * 64) = v; }
            asm volatile("s_waitcnt lgkmcnt(0)" ::: "memory");
        }
    } else {
        const float lam = C.lam; f32x4e dv[2][8]; float ssq[8];
#pragma unroll
        for (int i = 0; i < 8; ++i) ssq[i] = 0.f;
#pragma unroll
        for (int hf = 0; hf < 2; ++hf) {
#pragma unroll
            for (int r = 0; r < 16; ++r)
#pragma unroll
                for (int dd = 0; dd < 2; ++dd) stg[crow(r, hi) * 64 + dd * 32 + r32] = o[2 * hf + dd][r] * rli[r];
            asm volatile("s_waitcnt lgkmcnt(0)" ::: "memory");
#pragma unroll
            for (int i = 0; i < 8; ++i) { const f32x4e v = *(const f32x4e*)(stg + (i * 4 + srow) * 64 + scol); const f32x4e a = *(const f32x4e*)(gO + (size_t)i * 4 * 512 + hf * 64);
                const f32x4e d4 = a - lam * v; dv[hf][i] = d4; ssq[i] += (d4.x * d4.x + d4.y * d4.y) + (d4.z * d4.z + d4.w * d4.w); }
            asm volatile("s_waitcnt lgkmcnt(0)" ::: "memory");
        }
#pragma unroll
        for (int i = 0; i < 8; ++i) { float q = ssq[i]; q += __shfl_xor(q, 1); q += __shfl_xor(q, 2); q += __shfl_xor(q, 4); q += __shfl_xor(q, 8);
            ssq[i] = (1.f - LAM_INIT) * __builtin_amdgcn_rsqf(q * (1.f / 128.f) + EPS); }
        const bf16* sg = cur.SG + (size_t)(wid * QBLK + srow) * 512 + scol; bf16* yw = cur.Y + (size_t)(wid * QBLK + srow) * 1024 + scol;
#pragma unroll
        for (int hf = 0; hf < 2; ++hf) { const f32x4e gw = *(const f32x4e*)(C.subln_w + hf * 64 + scol);
#pragma unroll
            for (int i = 0; i < 8; ++i) { const u32x2e g = *(const u32x2e*)(sg + (size_t)i * 4 * 512 + hf * 64); const f32x4e d4 = dv[hf][i] * ssq[i] * gw; u32x2e w;
                w.x = cvtpk(d4.x * bflo(g.x), d4.y * bfhi(g.x)); w.y = cvtpk(d4.z * bflo(g.y), d4.w * bfhi(g.y));
                *(u32x2e*)(yw + (size_t)i * 4 * 1024 + hf * 64) = w; } }
    }
    __syncthreads();
#undef DA_RESC
#undef DA_KBASE
#undef DA_BIAS
#undef DA_MASKT
#undef DA_HALF_STEP
}
}

__device__ __forceinline__ void simple_gla(Frame& F) {
    LAS float* S = (LAS float*)F.lds;
    LAS float* Qi = S + 8192;
    LAS float* Ki = Qi + 4096;
    LAS float* Kst = Ki + 4096;
    LAS float* Vv = Kst + 4096;
    LAS float* Aa = Vv + 8192;
    LAS float* wtot = Aa + 4096;
    LAS float* dec = wtot + 512;
    const int tid = F.tid, d = tid & 63, w = tid >> 6;
    for (int u = blockIdx.x; u < BATCH * H; u += gridDim.x) {
        const int b = u / H, h = u % H;
        __syncthreads();
        for (int i = tid; i < 8192; i += 512) S[i] = 0.f;
        for (int n = 0; n < T / 64; ++n) {
            const size_t tok0 = (size_t)b * T + n * 64;
            float gl[8]; float run = 0.f;
#pragma unroll
            for (int i = 0; i < 8; ++i) { run += F.Gg[(tok0 + 8 * w + i) * 256 + h * 64 + d]; gl[i] = run; }
            __syncthreads();
            wtot[w * 64 + d] = run;
            __syncthreads();
            float off = 0.f, tot = 0.f;
#pragma unroll
            for (int ww = 0; ww < 8; ++ww) { const float v = wtot[ww * 64 + d]; tot += v; if (ww < w) off += v; }
#pragma unroll
            for (int i = 0; i < 8; ++i) { const int t = 8 * w + i; const float bb = gl[i] + off;
                const float qv = bf2f(F.QB[(tok0 + t) * 256 + h * 64 + d]), kv = bf2f(F.KB[(tok0 + t) * 256 + h * 64 + d]);
                Qi[t * 64 + d] = qv * __expf(bb); Ki[t * 64 + d] = kv * __expf(-bb); Kst[t * 64 + d] = kv * __expf(tot - bb); }
            if (w == 0) dec[d] = __expf(tot);
            { const int t = tid >> 3, seg = (tid & 7) * 16;
#pragma unroll
              for (int q2 = 0; q2 < 2; ++q2) { const v4u x = *(const GAS v4u*)(F.VB + (tok0 + t) * 512 + h * 128 + seg + q2 * 8);
                LAS float* e = Vv + t * 128 + seg + q2 * 8; e[0] = bflo(x.x); e[1] = bfhi(x.x); e[2] = bflo(x.y); e[3] = bfhi(x.y); e[4] = bflo(x.z); e[5] = bfhi(x.z); e[6] = bflo(x.w); e[7] = bfhi(x.w); } }
            __syncthreads();
            { const int c = tid >> 3, s0 = (tid & 7) * 8;
#pragma unroll
              for (int si = 0; si < 8; ++si) { const int s = s0 + si; float a = 0.f;
                  for (int dd = 0; dd < 64; ++dd) a += Qi[c * 64 + dd] * Ki[s * 64 + dd];
                  Aa[c * 64 + s] = (s <= c) ? a : 0.f; } }
            __syncthreads();
            { const int c = tid >> 3, e0 = (tid & 7) * 16; float o[16];
#pragma unroll
              for (int i = 0; i < 16; ++i) o[i] = 0.f;
              for (int s = 0; s < 64; ++s) { const float a = Aa[c * 64 + s], qv = Qi[c * 64 + s];
#pragma unroll
                  for (int i = 0; i < 16; ++i) o[i] += a * Vv[s * 128 + e0 + i] + qv * S[s * 128 + e0 + i]; }
              float ssq = 0.f;
#pragma unroll
              for (int i = 0; i < 16; ++i) ssq += o[i] * o[i];
              ssq += __shfl_xor(ssq, 1); ssq += __shfl_xor(ssq, 2); ssq += __shfl_xor(ssq, 4);
              const float rstd = 1.f / sqrtf(ssq * (1.f / 128.f) + EPS);
              const bf16* sg = F.SGB + (tok0 + c) * 512 + h * 128 + e0; bf16* y = F.Y + (tok0 + c) * 1024 + 512 + h * 128 + e0;
#pragma unroll
              for (int q2 = 0; q2 < 2; ++q2) { const v4u g = *(const GAS v4u*)(sg + q2 * 8); const float* gw = F.gla_w + e0 + q2 * 8; const float* oo = o + q2 * 8; v4u wv;
                  wv.x = pk2(oo[0] * rstd * gw[0] * bflo(g.x), oo[1] * rstd * gw[1] * bfhi(g.x));
                  wv.y = pk2(oo[2] * rstd * gw[2] * bflo(g.y), oo[3] * rstd * gw[3] * bfhi(g.y));
                  wv.z = pk2(oo[4] * rstd * gw[4] * bflo(g.z), oo[5] * rstd * gw[5] * bfhi(g.z));
                  wv.w = pk2(oo[6] * rstd * gw[6] * bflo(g.w), oo[7] * rstd * gw[7] * bfhi(g.w));
                  *(GAS v4u*)(y + q2 * 8) = wv; } }
            __syncthreads();
            { const int dd = tid >> 3, e0 = (tid & 7) * 16; float a[16]; const float dc = dec[dd];
#pragma unroll
              for (int i = 0; i < 16; ++i) a[i] = dc * S[dd * 128 + e0 + i];
              for (int t = 0; t < 64; ++t) { const float kv = Kst[t * 64 + dd];
#pragma unroll
                  for (int i = 0; i < 16; ++i) a[i] += kv * Vv[t * 128 + e0 + i]; }
#pragma unroll
              for (int i = 0; i < 16; ++i) S[dd * 128 + e0 + i] = a[i]; }
        }
    }
    __syncthreads();
}

__device__ __forceinline__ void final_norm(Frame& F) {
    const int gw = F.vcu * NWAVES + F.wave, NGW = F.G * NWAVES;
    f32x4 wv[4];
#pragma unroll
    for (int j = 0; j < 4; ++j) wv[j] = ((const GAS f32x4*)F.fin_w)[F.lane + 64 * j];
    for (int m = gw; m < M; m += NGW) {
        GAS f32x4* zr = (GAS f32x4*)(F.out + (size_t)m * D) + F.lane;
        f32x4 v[4]; float s = 0.f;
#pragma unroll
        for (int j = 0; j < 4; ++j) { v[j] = zr[64 * j]; s += (v[j].x * v[j].x + v[j].y * v[j].y) + (v[j].z * v[j].z + v[j].w * v[j].w); }
        const float rstd = 1.f / sqrtf(wave_sum(s) * (1.f / D) + EPS);
#pragma unroll
        for (int j = 0; j < 4; ++j) zr[64 * j] = v[j] * rstd * wv[j];
    }
}

namespace gla {
typedef short bf16x8 __attribute__((ext_vector_type(8)));
typedef unsigned u32x4 __attribute__((ext_vector_type(4)));
typedef unsigned u32x2 __attribute__((ext_vector_type(2)));
constexpr int RS = 72;
constexpr int L_QI = 0, L_KI = 9216, L_KT = 18432, L_VT = 27648, L_OST = 46080, OSR = 132, L_WTOT = L_OST + 64 * OSR * 4, L_DEC = L_WTOT + 2048, GLA_LDS = L_DEC + 256;
constexpr int GST_STRIDE = 8192 + 64;
typedef float f32x2_t __attribute__((ext_vector_type(2))); typedef __bf16 bf16x2_t __attribute__((ext_vector_type(2)));
__device__ __forceinline__ unsigned cvtpk(float lo, float hi) { f32x2_t v = {lo, hi}; bf16x2_t b = __builtin_convertvector(v, bf16x2_t); return __builtin_bit_cast(unsigned, b); }
__device__ __forceinline__ bf16x8 pack8(f32x4 a, f32x4 b) { u32x4 w = {cvtpk(a[0], a[1]), cvtpk(a[2], a[3]), cvtpk(b[0], b[1]), cvtpk(b[2], b[3])}; return __builtin_bit_cast(bf16x8, w); }
__device__ __forceinline__ bf16x8 join8(u32x2 a, u32x2 b) { u32x4 w = {a.x, a.y, b.x, b.y}; return __builtin_bit_cast(bf16x8, w); }
#define GLA_MFMA(a, b, c) __builtin_amdgcn_mfma_f32_16x16x32_bf16(a, b, c, 0, 0, 0)
template <bool OUT>
__device__ __forceinline__ void unit(Frame& F, char* ldsg, int b, int h, int sc) {
    LAS unsigned char* lds = (LAS unsigned char*)F.lds;
    LAS bf16* QI = (LAS bf16*)(lds + L_QI); LAS bf16* KI = (LAS bf16*)(lds + L_KI); LAS bf16* KT = (LAS bf16*)(lds + L_KT); LAS bf16* VT = (LAS bf16*)(lds + L_VT);
    LAS float* OST = (LAS float*)(lds + L_OST); LAS float* wtot = (LAS float*)(lds + L_WTOT); LAS float* dec = (LAS float*)(lds + L_DEC);
    const int tid = F.tid, lane = F.lane, w = F.wave, n = lane & 15, g = lane >> 4;
    const int bh = b * H + h;
    f32x4 S[4];
#pragma unroll
    for (int td = 0; td < 4; ++td) S[td] = (f32x4){0.f, 0.f, 0.f, 0.f};
    float logD = 0.f;
    if (OUT) {
        for (int s2 = 0; s2 < sc; ++s2) { const float* gs = F.GST + (size_t)(bh * 8 + s2) * GST_STRIDE;
#pragma unroll
            for (int td = 0; td < 4; ++td) { const f32x4 dl = *(const GAS f32x4*)(gs + 8192 + 16 * td + 4 * g);
#pragma unroll
                for (int r = 0; r < 4; ++r) S[td][r] = __expf(dl[r]) * S[td][r] + gs[(16 * td + 4 * g + r) * 128 + 16 * w + n]; } }
    }
    float gwv[16];
    if (OUT) {
#pragma unroll
        for (int i = 0; i < 16; ++i) gwv[i] = F.gla_w[(tid & 7) * 16 + i];
    }
    __syncthreads();
    for (int ch = 0; ch < 16; ++ch) {
        const size_t tok0 = (size_t)b * T + sc * 1024 + ch * 64;
        float gl[8]; float run = 0.f;
#pragma unroll
        for (int i = 0; i < 8; ++i) { run += F.Gg[(tok0 + 8 * w + i) * 256 + h * 64 + lane]; gl[i] = run; }
        unsigned short kk[8], qq[8];
#pragma unroll
        for (int i = 0; i < 8; ++i) { kk[i] = F.KB[(tok0 + 8 * w + i) * 256 + h * 64 + lane]; if (OUT) qq[i] = F.QB[(tok0 + 8 * w + i) * 256 + h * 64 + lane]; }
        const v4u v0 = *(const GAS v4u*)(F.VB + (tok0 + lane) * 512 + h * 128 + 16 * w), v1 = *(const GAS v4u*)(F.VB + (tok0 + lane) * 512 + h * 128 + 16 * w + 8);
        wtot[w * 64 + lane] = run;
        __syncthreads();
        float off = 0.f, tot = 0.f;
#pragma unroll
        for (int ww = 0; ww < 8; ++ww) { const float x = wtot[ww * 64 + lane]; tot += x; if (ww < w) off += x; }
        float kst[8];
#pragma unroll
        for (int i = 0; i < 8; ++i) { const int t = 8 * w + i; const float bb = gl[i] + off; const float kv = bf2f(kk[i]);
            kst[i] = kv * __expf(tot - bb);
            if (OUT) { QI[t * RS + lane] = (bf16)f2bf(bf2f(qq[i]) * __expf(bb)); KI[t * RS + lane] = (bf16)f2bf(kv * __expf(-bb)); } }
        { u32x4 pk = {cvtpk(kst[0], kst[1]), cvtpk(kst[2], kst[3]), cvtpk(kst[4], kst[5]), cvtpk(kst[6], kst[7])}; *(LAS u32x4*)(KT + lane * RS + 8 * w) = pk; }
        if (w == 0) dec[lane] = __expf(tot);
        { const unsigned vv[8] = {v0.x, v0.y, v0.z, v0.w, v1.x, v1.y, v1.z, v1.w};
#pragma unroll
          for (int i = 0; i < 8; ++i) { VT[(16 * w + 2 * i) * RS + lane] = (bf16)(vv[i] & 0xffffu); VT[(16 * w + 2 * i + 1) * RS + lane] = (bf16)(vv[i] >> 16); } }
        logD += tot;
        __syncthreads();
        f32x4 o[4];
        if (OUT) {
            bf16x8 af[4][2];
#pragma unroll
            for (int tc = 0; tc < 4; ++tc) {
                f32x4 at[4];
#pragma unroll
                for (int ts = 0; ts < 4; ++ts) { at[ts] = (f32x4){0.f, 0.f, 0.f, 0.f};
                    if (ts <= tc) {
#pragma unroll
                        for (int ks = 0; ks < 2; ++ks) { const bf16x8 A = *(const LAS bf16x8*)(KI + (16 * ts + n) * RS + 32 * ks + 8 * g), B = *(const LAS bf16x8*)(QI + (16 * tc + n) * RS + 32 * ks + 8 * g);
                            at[ts] = GLA_MFMA(A, B, at[ts]); }
                        if (ts == tc) {
#pragma unroll
                            for (int r = 0; r < 4; ++r) if (4 * g + r > n) at[ts][r] = 0.f; } } }
                af[tc][0] = pack8(at[0], at[1]); af[tc][1] = pack8(at[2], at[3]);
            }
#pragma unroll
            for (int tc = 0; tc < 4; ++tc) { o[tc] = (f32x4){0.f, 0.f, 0.f, 0.f};
#pragma unroll
                for (int ks = 0; ks < 2; ++ks) if (2 * ks <= tc) {
                    const u32x2 b0 = *(const LAS u32x2*)(VT + (16 * w + n) * RS + 32 * ks + 4 * g), b1 = *(const LAS u32x2*)(VT + (16 * w + n) * RS + 32 * ks + 16 + 4 * g);
                    o[tc] = GLA_MFMA(af[tc][ks], join8(b0, b1), o[tc]); } }
            const bf16x8 Sb0 = pack8(S[0], S[1]), Sb1 = pack8(S[2], S[3]);
#pragma unroll
            for (int tc = 0; tc < 4; ++tc) {
#pragma unroll
                for (int ks = 0; ks < 2; ++ks) {
                    const u32x2 a0 = *(const LAS u32x2*)(QI + (16 * tc + n) * RS + 32 * ks + 4 * g), a1 = *(const LAS u32x2*)(QI + (16 * tc + n) * RS + 32 * ks + 16 + 4 * g);
                    o[tc] = GLA_MFMA(join8(a0, a1), ks ? Sb1 : Sb0, o[tc]); } }
        }
#pragma unroll
        for (int td = 0; td < 4; ++td) { const f32x4 d4 = *(const LAS f32x4*)(dec + 16 * td + 4 * g); S[td] = S[td] * d4;
#pragma unroll
            for (int ks = 0; ks < 2; ++ks) { const bf16x8 A = *(const LAS bf16x8*)(KT + (16 * td + n) * RS + 32 * ks + 8 * g), B = *(const LAS bf16x8*)(VT + (16 * w + n) * RS + 32 * ks + 8 * g);
                S[td] = GLA_MFMA(A, B, S[td]); } }
        if (OUT) {
#pragma unroll
            for (int tc = 0; tc < 4; ++tc)
#pragma unroll
                for (int r = 0; r < 4; ++r) OST[(16 * tc + 4 * g + r) * OSR + 16 * w + n] = o[tc][r];
            __syncthreads();
            const int c = tid >> 3, seg = (tid & 7) * 16;
            f32x4 ov[4]; float ssq = 0.f;
#pragma unroll
            for (int i = 0; i < 4; ++i) { ov[i] = *(const LAS f32x4*)(OST + c * OSR + seg + 4 * i); ssq += (ov[i].x * ov[i].x + ov[i].y * ov[i].y) + (ov[i].z * ov[i].z + ov[i].w * ov[i].w); }
            ssq += __shfl_xor(ssq, 1); ssq += __shfl_xor(ssq, 2); ssq += __shfl_xor(ssq, 4);
            const float rstd = __builtin_amdgcn_rsqf(ssq * (1.f / 128.f) + EPS);
            const bf16* sg = F.SGB + (tok0 + c) * 512 + h * 128 + seg; bf16* y = F.Y + (tok0 + c) * 1024 + 512 + h * 128 + seg;
#pragma unroll
            for (int q2 = 0; q2 < 2; ++q2) { const v4u gt = *(const GAS v4u*)(sg + q2 * 8); const f32x4 a0 = ov[2 * q2] * rstd, a1 = ov[2 * q2 + 1] * rstd; const float* gw = gwv + q2 * 8; v4u wv;
                wv.x = cvtpk(a0.x * gw[0] * bflo(gt.x), a0.y * gw[1] * bfhi(gt.x)); wv.y = cvtpk(a0.z * gw[2] * bflo(gt.y), a0.w * gw[3] * bfhi(gt.y));
                wv.z = cvtpk(a1.x * gw[4] * bflo(gt.z), a1.y * gw[5] * bfhi(gt.z)); wv.w = cvtpk(a1.z * gw[6] * bflo(gt.w), a1.w * gw[7] * bfhi(gt.w));
                *(GAS v4u*)(y + q2 * 8) = wv; }
        }
    }
    if (!OUT) {
        float* gs = F.GST + (size_t)(bh * 8 + sc) * GST_STRIDE;
#pragma unroll
        for (int td = 0; td < 4; ++td)
#pragma unroll
            for (int r = 0; r < 4; ++r) gs[(16 * td + 4 * g + r) * 128 + 16 * w + n] = S[td][r];
        if (w == 0) gs[8192 + lane] = logD;
    }
    __syncthreads();
}
}

__device__ const unsigned char ATT_ORDER[128] = {127,126,125,124,123,122,121,120,119,118,117,116,115,114,113,112,95,94,93,92,91,90,89,88,87,86,85,84,83,82,81,80,79,111,78,110,77,109,76,108,75,107,74,106,73,105,72,104,71,103,70,102,69,101,63,62,61,60,59,58,57,56,55,54,53,52,51,50,49,48,47,46,45,44,43,42,41,40,39,38,37,36,68,100,35,67,99,34,66,98,31,30,29,28,27,26,25,24,23,22,21,20,19,18,17,16,15,14,13,12,11,10,9,8,7,6,5,4,3,2,1,33,65,97,0,32,64,96};
constexpr int ATT_ITEMS = 1024;
__device__ __forceinline__ da::BlockRef attn_ref(Frame& F, int item, int sub) {
    const int code = ATT_ORDER[item >> 3], b = item & 7, h = code >> 5, qb = code & 31;
    const size_t row0 = (size_t)b * T + (size_t)qb * da::QB;
    da::BlockRef r;
    r.Q = F.QA + row0 * 512 + h * 128 + sub * 64;
    r.K = F.KA + (size_t)b * T * 512 + h * 128 + sub * 64;
    r.V = F.VA + (size_t)b * T * 512 + h * 128;
    r.O1 = F.O1 + row0 * 512 + h * 128; r.Y = F.Y + row0 * 1024 + h * 128; r.SG = F.SGA + row0 * 512 + h * 128;
    r.P0 = qb * da::QB; r.sub = sub; r.slope2 = exp2f(-2.f * (float)(h + 1)) * LOG2E;
    const int idx = (b * 4 + h) * 2 + sub;
    const float k2 = __uint_as_float(__hip_atomic_load(F.ctl + CW_KM + idx * 2, RLX_AGENT)) + __uint_as_float(__hip_atomic_load(F.ctl + CW_KM + idx * 2 + 1, RLX_AGENT));
    const float q2 = __uint_as_float(__hip_atomic_load(F.ctl + CW_QM + (idx * 32 + qb) * 2, RLX_AGENT)) + __uint_as_float(__hip_atomic_load(F.ctl + CW_QM + (idx * 32 + qb) * 2 + 1, RLX_AGENT));
    const float qk = sqrtf(k2 * q2) * 1.01f + 0.01f;
    const float dcut = (SKIP_THRL + 2.f * qk) / r.slope2 + 1.f;
    const float jf = floorf(((float)(r.P0 - 63) - dcut) * (1.f / 64.f)) + 1.f;
    r.jlo = jf > 0.f ? (int)jf : 0;
    return r;
}
__device__ __forceinline__ int attn_fetch(Frame& F) {
    if (F.tid == 0) F.MISC[16] = __hip_atomic_fetch_add(F.ctl + CW_QCTR, 1u, RLX_AGENT);
    __syncthreads();
    return (int)F.MISC[16];
}
__device__ __forceinline__ void fast_attn(Frame& F, char* lds) {
    da::Consts C; C.lam = lambda_full(F); C.subln_w = F.subln_w;
    int item = attn_fetch(F), sub = 0;
    if (item < ATT_ITEMS) {
        da::Seam S;
        da::BlockRef cur = attn_ref(F, item, 0);
        da::prime(cur, lds, S);
        for (;;) {
            int nitem = item, nsub = 1; bool last = false;
            if (sub == 1) { nitem = attn_fetch(F); nsub = 0; last = nitem >= ATT_ITEMS; }
            const da::BlockRef nxt = last ? cur : attn_ref(F, nitem, nsub);
            da::block(cur, nxt, lds, S, C);
            if (last) break;
            cur = nxt; item = nitem; sub = nsub;
        }
    }
    asm volatile("s_waitcnt vmcnt(0)" ::: "memory");
    __syncthreads();
}

struct Args { const float* in[13]; float* out; unsigned char* ws; int ph_lo, ph_hi, li, pad; };
__global__ void __launch_bounds__(NWAVES * 64, 2) hybrid_fwd(Args args) {
    extern __shared__ __attribute__((aligned(16))) unsigned char lds[];
    Frame F;
    F.lds = (LAS unsigned char*)lds;
    F.MISC = (volatile LAS unsigned*)(F.lds + MISC_OFF);
    F.tid = threadIdx.x; F.lane = F.tid & 63; F.wave = __builtin_amdgcn_readfirstlane(F.tid >> 6);
    F.G = gridDim.x; { const int bx = blockIdx.x; F.vcu = (F.G % 8 == 0) ? (bx % 8) * (F.G / 8) + bx / 8 : bx; }
    unsigned char* ws = args.ws;
    F.ctl = (gu32*)(ws + WS_CTL);
    F.x = args.in[0]; F.norm_w = args.in[1]; F.w_in = args.in[2]; F.w_gate_up = args.in[3]; F.b_gate = args.in[4];
    F.lq1 = args.in[5]; F.lk1 = args.in[6]; F.lq2 = args.in[7]; F.lk2 = args.in[8]; F.subln_w = args.in[9]; F.gla_w = args.in[10];
    F.w_out = args.in[11]; F.fin_w = args.in[12]; F.out = args.out;
    F.Win_t = (bf16*)(ws + WS_WIN); F.Wout_t = (bf16*)(ws + WS_WOUT); F.XN = (bf16*)(ws + WS_XN); F.Y = (bf16*)(ws + WS_Y);
    F.QA = (bf16*)(ws + WS_QA); F.KA = (bf16*)(ws + WS_KA); F.VA = (bf16*)(ws + WS_VA); F.SGA = (bf16*)(ws + WS_SGA);
    F.QB = (bf16*)(ws + WS_QB); F.KB = (bf16*)(ws + WS_KB); F.VB = (bf16*)(ws + WS_VB); F.SGB = (bf16*)(ws + WS_SGB);
    F.Gg = (float*)(ws + WS_G); F.O1 = (float*)(ws + WS_O1); F.GST = (float*)(ws + WS_GST);
    for (int u = F.tid; u < (LDS_BYTES - LDSCTL_OFF) / 4; u += NWAVES * 64) ((LAS unsigned*)(F.lds + LDSCTL_OFF))[u] = 0u;
    __syncthreads();
    XcdBarrier bar; bar.bar = (unsigned*)(F.ctl + CW_BAR); bar.x = 0; bar.st = nullptr;
    if (N_LAUNCHES != PER_PHASE) bar = xcd_barrier_post((unsigned*)(F.ctl + CW_BAR), F.MISC + 8);
#define GRID_BAR(seam) do { if (N_LAUNCHES == PER_PHASE) { if (F.tid == 0) __hip_atomic_store(F.ctl + CW_TMO, 0xBADBA0u | (unsigned)(seam), RLX_AGENT); } else { xcd_barrier(bar); } } while (0)
    const int lo = args.ph_lo, hi = args.ph_hi;
#define IN(k) (lo <= (k) && (k) < hi)
#define BOTH(k) (IN(k) && IN((k) + 1))
    if (IN(0)) { p0_prologue(F); if (BOTH(0)) GRID_BAR(0); }
    if (IN(1)) {
        pg8::Gemm g{F.XN, F.Win_t, M, NP, D}; pg8::StaticOrder S; S.init(M, NP, F.G, (int)blockIdx.x);
        pg8::EpiProjFast E{F.QA, F.KA, F.VA, F.SGA, F.QB, F.KB, F.VB, F.SGB, F.Gg, F.b_gate, (unsigned*)(F.ctl + CW_KM), (unsigned*)(F.ctl + CW_QM)};
        pg8::gemm_phase<pg8::EpiProjFast, pg8::StaticOrder, true, true>(F.lds, g, S, E);
        if (BOTH(1)) GRID_BAR(1);
    }
    if (IN(2)) { if (F.G == 256 && (F.vcu & 7) != 7) gla::unit<false>(F, (char*)lds, F.vcu >> 5, (F.vcu >> 3) & 3, F.vcu & 7); if (BOTH(2)) GRID_BAR(2); }
    if (IN(3)) { if (F.G == 256) { fast_attn(F, (char*)lds); gla::unit<true>(F, (char*)lds, F.vcu >> 5, (F.vcu >> 3) & 3, F.vcu & 7); } else { simple_attn(F); simple_gla(F); } if (BOTH(3)) GRID_BAR(3); }
    if (IN(4)) {
        pg8::Gemm g{F.Y, F.Wout_t, M, D, D}; pg8::StaticOrder S; S.init(M, D, F.G, (int)blockIdx.x);
        pg8::EpiResFast E{F.x, F.out};
        pg8::gemm_phase<pg8::EpiResFast, pg8::StaticOrder, true, true>(F.lds, g, S, E);
        if (BOTH(4)) GRID_BAR(4);
    }
    if (IN(5)) { final_norm(F); }
#undef IN
#undef BOTH
}

extern "C" void kernel_launch(void* const* d_in, const int* in_sizes, int n_in, void* d_out, int out_size, void* d_ws, size_t ws_size, hipStream_t stream) {
    static int grid = 0;
    if (grid == 0) {
        if (n_in != 13 || in_sizes[0] != M * D || out_size != M * D || ws_size < WS_END) { fprintf(stderr, "kernel_launch: shape/workspace mismatch (n_in %d, in0 %d, out %d, ws %zu)\n", n_in, n_in > 0 ? in_sizes[0] : -1, out_size, ws_size); grid = -1; return; }
        int dev = 0, cus = 0, per_cu = 0;
        if (hipGetDevice(&dev) != hipSuccess || hipDeviceGetAttribute(&cus, hipDeviceAttributeMultiprocessorCount, dev) != hipSuccess) { grid = -1; return; }
        if (hipFuncSetAttribute((const void*)hybrid_fwd, hipFuncAttributeMaxDynamicSharedMemorySize, LDS_BYTES) != hipSuccess) { fprintf(stderr, "kernel_launch: hipFuncSetAttribute failed\n"); grid = -1; return; }
        if (hipOccupancyMaxActiveBlocksPerMultiprocessor(&per_cu, (const void*)hybrid_fwd, NWAVES * 64, LDS_BYTES) != hipSuccess || per_cu < 1) { fprintf(stderr, "kernel_launch: occupancy query says %d\n", per_cu); per_cu = 1; }
        (void)hipGetLastError();
        grid = cus;
    }
    if (grid < 0) return;
    (void)hipMemsetAsync((char*)d_ws + WS_CTL, 0, CTL_ZERO_BYTES, stream);
    Args a{};
    for (int i = 0; i < 13; ++i) a.in[i] = (const float*)d_in[i];
    a.out = (float*)d_out; a.ws = (unsigned char*)d_ws;
    if (N_LAUNCHES == 1) { a.ph_lo = 0; a.ph_hi = PER_PHASE; a.li = 0; hipLaunchKernelGGL(hybrid_fwd, dim3(grid), dim3(NWAVES * 64), LDS_BYTES, stream, a); }
    else for (int li = 0; li < PER_PHASE; ++li) { a.ph_lo = li; a.ph_hi = li + 1; a.li = li; hipLaunchKernelGGL(hybrid_fwd, dim3(grid), dim3(NWAVES * 64), LDS_BYTES, stream, a); }
}
```
